# Optimizing an MI355X kernel written in HIP

```python
import jax, jax.numpy as jnp
from jax import lax
import numpy as np

D_MODEL = 2048
BATCH = 4
SEQ = 2048
DEPTH = 4

CHUNK = 64
A_HEAD_DIM = 128
A_WIDTH = D_MODEL // 2
A_HEADS = A_WIDTH // A_HEAD_DIM
A_LEFT_CHUNKS = 8
A_BAND = A_LEFT_CHUNKS + 1
A_MAX_REL = 256
B_WIDTH = D_MODEL - A_WIDTH
CONV_WIDTH = 3
C_BLOCK = 128
C_WIDTH = D_MODEL
C_GROUPS = 8
FFN_HIDDEN = -(-8 * D_MODEL // (3 * 256)) * 256
N_EVEN = (DEPTH + 1) // 2
N_ODD = DEPTH // 2
EPS = 1e-6
NEG_INF = -1e30

kernel_name = 'hybrid_chunk_attn_conv_gmlp_trunk'


def rms_norm(x, g):
    x32 = x.astype(jnp.float32)
    y = x32 * lax.rsqrt(jnp.mean(x32 * x32, axis=-1, keepdims=True) + EPS)
    return (y * g.astype(jnp.float32)).astype(x.dtype)


def layer_norm(x, g, b):
    x32 = x.astype(jnp.float32)
    mu = jnp.mean(x32, axis=-1, keepdims=True)
    xc = x32 - mu
    var = jnp.mean(xc * xc, axis=-1, keepdims=True)
    y = xc * lax.rsqrt(var + EPS) * g.astype(jnp.float32) + b.astype(jnp.float32)
    return y.astype(x.dtype)


def band_attention(q, k, v, rel_bias):
    bsz, seq, heads, dh = q.shape
    nc = seq // CHUNK
    qc = q.reshape(bsz, nc, CHUNK, heads, dh)
    pad = ((0, 0), (A_LEFT_CHUNKS * CHUNK, 0), (0, 0), (0, 0))
    kp = jnp.pad(k, pad).reshape(bsz, nc + A_LEFT_CHUNKS, CHUNK, heads, dh)
    vp = jnp.pad(v, pad).reshape(bsz, nc + A_LEFT_CHUNKS, CHUNK, heads, dh)
    band_idx = jnp.arange(nc)[:, None] + jnp.arange(A_BAND)[None, :]
    kb = kp[:, band_idx].reshape(bsz, nc, A_BAND * CHUNK, heads, dh)
    vb = vp[:, band_idx].reshape(bsz, nc, A_BAND * CHUNK, heads, dh)
    scores = jnp.einsum('bnqhd,bnkhd->bhnqk', qc, kb).astype(jnp.float32) * (dh ** -0.5)
    q_pos = jnp.arange(CHUNK)[:, None] + A_LEFT_CHUNKS * CHUNK
    k_pos = jnp.arange(A_BAND * CHUNK)[None, :]
    rel_idx = jnp.clip(q_pos - k_pos, -A_MAX_REL, A_MAX_REL) + A_MAX_REL
    bias = rel_bias.astype(jnp.float32)[:, rel_idx]
    scores = scores + bias[:, None]
    valid = jnp.repeat(band_idx >= A_LEFT_CHUNKS, CHUNK, axis=1)
    scores = jnp.where(valid[None, None, :, None, :], scores, NEG_INF)
    p = jax.nn.softmax(scores, axis=-1).astype(v.dtype)
    out = jnp.einsum('bhnqk,bnkhd->bnqhd', p, vb)
    return out.reshape(bsz, seq, heads * dh)


def gated_short_conv(b_gate, c_gate, h, conv_w):
    z = c_gate * h
    seq = z.shape[1]
    zp = jnp.pad(z, ((0, 0), (CONV_WIDTH - 1, 0), (0, 0)))
    y = conv_w[0] * zp[:, 0:seq]
    for j in range(1, CONV_WIDTH):
        y = y + conv_w[j] * zp[:, j:j + seq]
    return b_gate * y


def mixer_ab(h, w_in, rel_bias, conv_w, w_out):
    bsz, seq, _ = h.shape
    proj = h @ w_in
    cuts = [A_WIDTH, 2 * A_WIDTH, 3 * A_WIDTH, 3 * A_WIDTH + B_WIDTH, 3 * A_WIDTH + 2 * B_WIDTH]
    q, k, v, b_gate, c_gate, hv = jnp.split(proj, cuts, axis=-1)
    shp = (bsz, seq, A_HEADS, A_HEAD_DIM)
    attn = band_attention(q.reshape(shp), k.reshape(shp), v.reshape(shp), rel_bias)
    conv = gated_short_conv(b_gate, c_gate, hv, conv_w)
    return jnp.concatenate([attn, conv], axis=-1) @ w_out


def mixer_c(h, w_in, ln_g, ln_b, w_s, b_s, w_out):
    bsz, seq, _ = h.shape
    nb = seq // C_BLOCK
    z = jax.nn.gelu(h @ w_in, approximate=False)
    u, v = jnp.split(z, 2, axis=-1)
    v = layer_norm(v, ln_g, ln_b)
    pos = jnp.arange(C_BLOCK)
    mask = (pos[None, :] // CHUNK) <= (pos[:, None] // CHUNK)
    w_m = jnp.where(mask[None], w_s, jnp.zeros_like(w_s))
    vg = v.reshape(bsz, nb, C_BLOCK, C_GROUPS, C_WIDTH // C_GROUPS)
    s = jnp.einsum('gts,bnsgd->bntgd', w_m, vg) + jnp.transpose(b_s)[:, :, None]
    return (u * s.reshape(bsz, seq, C_WIDTH)) @ w_out


def swiglu(h, w_gate, w_up, w_down):
    return (jax.nn.silu(h @ w_gate) * (h @ w_up)) @ w_down


def setup_inputs(seed: int = 0) -> dict:
    key = jax.random.key(seed)
    ks = jax.random.split(key, 17)
    nrm = jax.random.normal
    f32 = jnp.float32
    in_ab = 3 * A_WIDTH + 3 * B_WIDTH
    return {
        'x': nrm(ks[0], (BATCH, SEQ, D_MODEL), f32),
        'mix_norm': 1.0 + 0.02 * nrm(ks[1], (DEPTH, D_MODEL), f32),
        'ab_w_in': nrm(ks[2], (N_EVEN, D_MODEL, in_ab), f32) * D_MODEL ** -0.5,
        'ab_rel_bias': 0.5 * nrm(ks[3], (N_EVEN, A_HEADS, 2 * A_MAX_REL + 1), f32),
        'ab_conv_w': nrm(ks[4], (N_EVEN, CONV_WIDTH, B_WIDTH), f32) * CONV_WIDTH ** -0.5,
        'ab_w_out': nrm(ks[5], (N_EVEN, A_WIDTH + B_WIDTH, D_MODEL), f32) * (A_WIDTH + B_WIDTH) ** -0.5,
        'c_w_in': nrm(ks[6], (N_ODD, D_MODEL, 2 * C_WIDTH), f32) * D_MODEL ** -0.5,
        'c_ln_g': 1.0 + 0.02 * nrm(ks[7], (N_ODD, C_WIDTH), f32),
        'c_ln_b': 0.02 * nrm(ks[8], (N_ODD, C_WIDTH), f32),
        'c_w_s': nrm(ks[9], (N_ODD, C_GROUPS, C_BLOCK, C_BLOCK), f32) * C_BLOCK ** -0.5,
        'c_b_s': 1.0 + 0.02 * nrm(ks[10], (N_ODD, C_GROUPS, C_BLOCK), f32),
        'c_w_out': nrm(ks[11], (N_ODD, C_WIDTH, D_MODEL), f32) * C_WIDTH ** -0.5,
        'ffn_norm': 1.0 + 0.02 * nrm(ks[12], (DEPTH, D_MODEL), f32),
        'ffn_w_gate': nrm(ks[13], (DEPTH, D_MODEL, FFN_HIDDEN), f32) * D_MODEL ** -0.5,
        'ffn_w_up': nrm(ks[14], (DEPTH, D_MODEL, FFN_HIDDEN), f32) * D_MODEL ** -0.5,
        'ffn_w_down': nrm(ks[15], (DEPTH, FFN_HIDDEN, D_MODEL), f32) * FFN_HIDDEN ** -0.5,
        'final_norm': 1.0 + 0.02 * nrm(ks[16], (D_MODEL,), f32),
    }


def reference(x, mix_norm, ab_w_in, ab_rel_bias, ab_conv_w, ab_w_out, c_w_in, c_ln_g, c_ln_b,
              c_w_s, c_b_s, c_w_out, ffn_norm, ffn_w_gate, ffn_w_up, ffn_w_down, final_norm):
    for layer in range(DEPTH):
        i = layer // 2
        h = rms_norm(x, mix_norm[layer])
        if layer % 2 == 0:
            x = x + mixer_ab(h, ab_w_in[i], ab_rel_bias[i], ab_conv_w[i], ab_w_out[i])
        else:
            x = x + mixer_c(h, c_w_in[i], c_ln_g[i], c_ln_b[i], c_w_s[i], c_b_s[i], c_w_out[i])
        h = rms_norm(x, ffn_norm[layer])
        x = x + swiglu(h, ffn_w_gate[layer], ffn_w_up[layer], ffn_w_down[layer])
    return rms_norm(x, final_norm)
```

```cpp
#include <hip/hip_runtime.h>
#include <hip/hip_cooperative_groups.h>
#include <cstdio>
#include <cstdint>
namespace cg = cooperative_groups;
namespace pg8 {
#define PG8_LAS __attribute__((address_space(3)))
typedef unsigned short bf16_t;
typedef short bf16x8 __attribute__((ext_vector_type(8)));
typedef float f32x4 __attribute__((ext_vector_type(4)));
typedef unsigned u32x4 __attribute__((ext_vector_type(4)));
constexpr int BM = 256, BK = 64, HALF = 128, HTB = HALF * BK * 2  , STAGE_BYTES = 8 * HTB, NXCD = 8, WGM = 8;

__host__ __device__ __forceinline__ int lds_byte(int r, int c) { const int st = (r >> 4) * 2 + (c >> 5), rr = r & 15, cc = c & 31, ob = rr * 64 + cc * 2; return st * 1024 + (ob ^ (((ob >> 9) & 1) << 5)); }
__host__ __device__ __forceinline__ void stage_rc(int b, int& R, int& C) { const int st = b / 1024, sb = b % 1024, swz = sb ^ (((sb >> 9) & 1) << 5); R = (st >> 1) * 16 + swz / 64; C = (st & 1) * 32 + (swz % 64) / 2; }
__host__ __device__ __forceinline__ int perm32(int rho) { const int n = rho >> 4, i = rho & 15; return 8 * (i >> 2) + 4 * n + (i & 3); }

struct Unit { int pm, pn; };
struct Gemm { const bf16_t* A; const bf16_t* Bt; int M, N, K; };

struct StaticOrder {
    int nM, nN, nwg, G, c;
    __host__ __device__ void init(int M, int N, int G_, int c_) { nM = M / BM; nN = N / BM; nwg = nM * nN; G = G_; c = c_; }
    __host__ __device__ bool next(int i, Unit& u) const {
        const long L = (long)i * G + c; if (L >= nwg) return false;
        int wgid = (int)L; { const int q = nwg / NXCD, r = nwg % NXCD, xcd = wgid % NXCD, off = wgid / NXCD; wgid = (xcd < r ? xcd * (q + 1) : r * (q + 1) + (xcd - r) * q) + off; }
        const int nig = WGM * nN, gid = wgid / nig, fm = gid * WGM, gsz = (nM - fm) < WGM ? (nM - fm) : WGM;
        u.pm = fm + ((wgid % nig) % gsz); u.pn = (wgid % nig) / gsz; return true;
    }
    __device__ __forceinline__ void a_ready(const Unit&) const {}
    __device__ __forceinline__ void done(const Unit&) const {}
};

typedef float cvt_f32x2 __attribute__((ext_vector_type(2))); typedef __bf16 cvt_bf16x2 __attribute__((ext_vector_type(2)));
__device__ __forceinline__ unsigned cvt_pk_bf16(float lo, float hi) { const cvt_f32x2 v = {lo, hi}; return __builtin_bit_cast(unsigned, __builtin_convertvector(v, cvt_bf16x2)); }
typedef float f32x2 __attribute__((ext_vector_type(2)));
__device__ __forceinline__ f32x2 gelu_pk(f32x2 v) {
    const f32x2 av = __builtin_elementwise_abs(v), d = av * 0.2316418882f + 1.0f;
    f32x2 t; t.x = __builtin_amdgcn_rcpf(d.x); t.y = __builtin_amdgcn_rcpf(d.y);
    f32x2 q = t * 0.5307027145f + (-0.7265760135f); q = q * t + 0.7107068705f; q = q * t + (-0.142248368f); q = q * t + 0.127414796f; q = q * t;
    const f32x2 s = (v * v) * (-0.72134752044f);
    f32x2 e; e.x = __builtin_amdgcn_exp2f(s.x); e.y = __builtin_amdgcn_exp2f(s.y);
    const f32x2 m = v * (q * e), r = v - m;
    f32x2 o; o.x = v.x < 0.f ? m.x : r.x; o.y = v.y < 0.f ? m.y : r.y; return o;
}
constexpr float RMS_EPS = 1e-6f;
__device__ __forceinline__ float row_rs(const float* stats, int row) {
    const f32x4 a = *(const f32x4*)(stats + (size_t)row * 8), b = *(const f32x4*)(stats + (size_t)row * 8 + 4);
    const float s = ((a[0] + a[1]) + (a[2] + a[3])) + ((b[0] + b[1]) + (b[2] + b[3]));
    return __builtin_amdgcn_rsqf(s * (1.0f / 2048.0f) + RMS_EPS);
}
#define RS_LOOKUP() ((u.pm == pm0) ? rstab[ai * HALF + wr * 64 + m * 16 + fr] : row_rs(stats, row))
struct EpiScaleBf16 {
    static constexpr bool PERM = true, AFTER_DRAIN = false;
    bf16_t* O; int ldc; const float* stats; const PG8_LAS float* rstab; int pm0;
    __device__ __forceinline__ void prefill(int tid) const { if (pm0 >= 0 && tid < 256) ((PG8_LAS float*)rstab)[tid] = row_rs(stats, pm0 * BM + tid); }
    __device__ __forceinline__ void operator()(const f32x4 (&acc)[2][2][4][2], const Unit& u, int wr, int wc, int fr, int fq) const {
        const int row0 = u.pm * BM + wr * 64 + fr, col0 = u.pn * BM + wc * 32 + 8 * fq;
#pragma unroll
        for (int ai = 0; ai < 2; ++ai)
#pragma unroll
            for (int m = 0; m < 4; ++m) { const int row = row0 + ai * HALF + m * 16; const float rs = RS_LOOKUP(); bf16_t* rowp = O + (size_t)row * ldc + col0;
#pragma unroll
                for (int bj = 0; bj < 2; ++bj) { const f32x4 v0 = acc[ai][bj][m][0] * rs, v1 = acc[ai][bj][m][1] * rs;
                    u32x4 w; w.x = cvt_pk_bf16(v0[0], v0[1]); w.y = cvt_pk_bf16(v0[2], v0[3]); w.z = cvt_pk_bf16(v1[0], v1[1]); w.w = cvt_pk_bf16(v1[2], v1[3]);
                    *(u32x4*)(rowp + bj * HALF) = w; } }
    }
};
__device__ __forceinline__ float silu_mul(float g, float u) { return g * u * __builtin_amdgcn_rcpf(1.0f + __builtin_amdgcn_exp2f(g * -1.4426950408889634f)); }
struct EpiSwiGLU {
    static constexpr bool PERM = true, AFTER_DRAIN = false;
    bf16_t* O; int ldc; const float* stats; const PG8_LAS float* rstab; int pm0;
    __device__ __forceinline__ void prefill(int tid) const { if (pm0 >= 0 && tid < 256) ((PG8_LAS float*)rstab)[tid] = row_rs(stats, pm0 * BM + tid); }
    __device__ __forceinline__ void operator()(const f32x4 (&acc)[2][2][4][2], const Unit& u, int wr, int wc, int fr, int fq) const {
        const int row0 = u.pm * BM + wr * 64 + fr, col0 = u.pn * HALF + wc * 32 + 8 * fq;
#pragma unroll
        for (int ai = 0; ai < 2; ++ai)
#pragma unroll
            for (int m = 0; m < 4; ++m) { const int row = row0 + ai * HALF + m * 16; const float rs = RS_LOOKUP();
                const f32x4 g0 = acc[ai][0][m][0] * rs, g1 = acc[ai][0][m][1] * rs, u0 = acc[ai][1][m][0] * rs, u1 = acc[ai][1][m][1] * rs;
                u32x4 w; w.x = cvt_pk_bf16(silu_mul(g0[0], u0[0]), silu_mul(g0[1], u0[1])); w.y = cvt_pk_bf16(silu_mul(g0[2], u0[2]), silu_mul(g0[3], u0[3]));
                w.z = cvt_pk_bf16(silu_mul(g1[0], u1[0]), silu_mul(g1[1], u1[1])); w.w = cvt_pk_bf16(silu_mul(g1[2], u1[2]), silu_mul(g1[3], u1[3]));
                *(u32x4*)(O + (size_t)row * ldc + col0) = w; }
    }
};
struct EpiGeluLN {
    static constexpr bool PERM = true, AFTER_DRAIN = false;
    bf16_t* O; int ldc; const float* stats; float* lnp; const PG8_LAS float* rstab; int pm0;
    __device__ __forceinline__ void prefill(int tid) const { if (pm0 >= 0 && tid < 256) ((PG8_LAS float*)rstab)[tid] = row_rs(stats, pm0 * BM + tid); }
    __device__ __forceinline__ void operator()(const f32x4 (&acc)[2][2][4][2], const Unit& u, int wr, int wc, int fr, int fq) const {
        const int row0 = u.pm * BM + wr * 64 + fr, col0 = u.pn * BM + wc * 32 + 8 * fq;
#pragma unroll
        for (int ai = 0; ai < 2; ++ai)
#pragma unroll
            for (int m = 0; m < 4; ++m) { const int row = row0 + ai * HALF + m * 16; const float rs = RS_LOOKUP(); bf16_t* rowp = O + (size_t)row * ldc + col0; float s = 0.f, q = 0.f;
#pragma unroll
                for (int bj = 0; bj < 2; ++bj) { f32x4 v0 = acc[ai][bj][m][0] * rs, v1 = acc[ai][bj][m][1] * rs;
                    { f32x2 a = gelu_pk((f32x2){v0[0], v0[1]}), b = gelu_pk((f32x2){v0[2], v0[3]}), c = gelu_pk((f32x2){v1[0], v1[1]}), d = gelu_pk((f32x2){v1[2], v1[3]});
                      v0 = (f32x4){a.x, a.y, b.x, b.y}; v1 = (f32x4){c.x, c.y, d.x, d.y}; }
                    s += ((v0[0] + v0[1]) + (v0[2] + v0[3])) + ((v1[0] + v1[1]) + (v1[2] + v1[3]));
                    q += ((v0[0] * v0[0] + v0[1] * v0[1]) + (v0[2] * v0[2] + v0[3] * v0[3])) + ((v1[0] * v1[0] + v1[1] * v1[1]) + (v1[2] * v1[2] + v1[3] * v1[3]));
                    u32x4 w; w.x = cvt_pk_bf16(v0[0], v0[1]); w.y = cvt_pk_bf16(v0[2], v0[3]); w.z = cvt_pk_bf16(v1[0], v1[1]); w.w = cvt_pk_bf16(v1[2], v1[3]);
                    *(u32x4*)(rowp + bj * HALF) = w; }
                if (u.pn >= 8) { s += __shfl_xor(s, 16); s += __shfl_xor(s, 32); q += __shfl_xor(q, 16); q += __shfl_xor(q, 32);
                    if (fq == 0) *(f32x2*)(lnp + ((size_t)row * 32 + (u.pn - 8) * 4 + wc) * 2) = (f32x2){s, q}; } }
    }
};
struct EpiResidual {
    static constexpr bool PERM = true, AFTER_DRAIN = true;
    bf16_t* xb; float* xout; float* stats; int ldc;
    __device__ __forceinline__ void prefill(int) const {}
    __device__ __forceinline__ void init(f32x4 (&acc)[2][2][4][2], const Unit& u, int wr, int wc, int fr, int fq) const {
        const int col0 = u.pn * BM + wc * 32 + 8 * fq;
#pragma unroll
        for (int ai = 0; ai < 2; ++ai)
#pragma unroll
            for (int m = 0; m < 4; ++m) { const int r = ai * HALF + wr * 64 + m * 16 + fr; const size_t off = (size_t)(u.pm * BM + r) * ldc + col0;
#pragma unroll
                for (int bj = 0; bj < 2; ++bj) { const u32x4 xw = *(const u32x4*)(xb + off + bj * HALF);
                    acc[ai][bj][m][0] = (f32x4){__uint_as_float(xw.x << 16), __uint_as_float(xw.x & 0xffff0000u), __uint_as_float(xw.y << 16), __uint_as_float(xw.y & 0xffff0000u)};
                    acc[ai][bj][m][1] = (f32x4){__uint_as_float(xw.z << 16), __uint_as_float(xw.z & 0xffff0000u), __uint_as_float(xw.w << 16), __uint_as_float(xw.w & 0xffff0000u)}; } }
    }
    __device__ __forceinline__ void fused(f32x4 (&acc)[2][2][4][2], const Unit& u, int wr, int wc, int fr, int fq, PG8_LAS unsigned char* lds, int wid, int lane) const {
        PG8_LAS float* P = (PG8_LAS float*)lds;
        const int col0 = u.pn * BM + wc * 32 + 8 * fq;
#pragma unroll
        for (int ai = 0; ai < 2; ++ai)
#pragma unroll
            for (int m = 0; m < 4; ++m) { const int r = ai * HALF + wr * 64 + m * 16 + fr; const size_t off = (size_t)(u.pm * BM + r) * ldc + col0; float q = 0.f;
#pragma unroll
                for (int bj = 0; bj < 2; ++bj) { const f32x4 o0 = acc[ai][bj][m][0], o1 = acc[ai][bj][m][1];
                    u32x4 w; w.x = cvt_pk_bf16(o0[0], o0[1]); w.y = cvt_pk_bf16(o0[2], o0[3]); w.z = cvt_pk_bf16(o1[0], o1[1]); w.w = cvt_pk_bf16(o1[2], o1[3]);
                    *(u32x4*)(xb + off + bj * HALF) = w;
                    const float r0 = __uint_as_float(w.x << 16), r1 = __uint_as_float(w.x & 0xffff0000u), r2 = __uint_as_float(w.y << 16), r3 = __uint_as_float(w.y & 0xffff0000u);
                    const float r4 = __uint_as_float(w.z << 16), r5 = __uint_as_float(w.z & 0xffff0000u), r6 = __uint_as_float(w.w << 16), r7 = __uint_as_float(w.w & 0xffff0000u);
                    q += ((r0 * r0 + r1 * r1) + (r2 * r2 + r3 * r3)) + ((r4 * r4 + r5 * r5) + (r6 * r6 + r7 * r7)); }
                q += __shfl_xor(q, 16); q += __shfl_xor(q, 32);
                if (fq == 0) P[r * 4 + wc] = q;
                }
        asm volatile("s_waitcnt lgkmcnt(0)" ::: "memory"); __builtin_amdgcn_s_barrier(); asm volatile("" ::: "memory");
        const int tid = wid * 64 + lane;
        if (tid < 256) { const f32x4 p = *(const PG8_LAS f32x4*)(P + tid * 4); stats[(size_t)(u.pm * BM + tid) * 8 + u.pn] = (p[0] + p[1]) + (p[2] + p[3]); }
    }
};

template <class Epi, class Sched, bool ALIGN_EPI = false, bool SP2 = false>
__device__ __forceinline__ void gemm_phase(PG8_LAS unsigned char* lds, const Gemm g, const Sched& S, const Epi& E, const int tid) {
    const int wid = __builtin_amdgcn_readfirstlane(tid >> 6), lane = tid & 63, wr = wid >> 2, wc = wid & 3, fr = lane & 15, fq = lane >> 4;
    const int K = g.K, nt = K / BK;
    unsigned voffA[2], voffB[2];
#pragma unroll
    for (int i = 0; i < 2; ++i) { int R, C; stage_rc(tid * 16 + i * 8192, R, C); const int Rb = Epi::PERM ? ((R & ~31) + perm32(R & 31)) : R;
        voffA[i] = (unsigned)(R * K + C) * 2u; voffB[i] = (unsigned)(Rb * K + C) * 2u; }
    const size_t kstep = (size_t)(BK * 2);
    const size_t hstep = (size_t)HALF * K * 2;
    const size_t tstep = 2 * hstep;
    const unsigned ldsw = (unsigned)wid * 1024u;
    const int aoff = lds_byte(wr * 64 + fr, fq * 8), boff = lds_byte(wc * 32 + fr, fq * 8);
#define PG8_SA(b, h) (((b) * 2 + (h)) * HTB)
#define PG8_SB(b, h) ((4 + (b) * 2 + (h)) * HTB)
#define PG8_STAGE(bufoff, gbase, voff) do { _Pragma("unroll") for (int _i = 0; _i < 2; ++_i) \
        __builtin_amdgcn_global_load_lds((const unsigned*)((const char*)(gbase) + (voff)[_i]), (PG8_LAS unsigned*)(lds + (bufoff) + ldsw + _i * 8192), 16, 0, 0); } while (0)
#define PG8_LDA(dst, b, h) do { _Pragma("unroll") for (int m = 0; m < 4; ++m) _Pragma("unroll") for (int k = 0; k < 2; ++k) dst[m][k] = *(const PG8_LAS bf16x8*)(lds + PG8_SA(b, h) + aoff + m * 2048 + k * 1024); } while (0)
#define PG8_LDB(dst, b, h) do { _Pragma("unroll") for (int n = 0; n < 2; ++n) _Pragma("unroll") for (int k = 0; k < 2; ++k) dst[n][k] = *(const PG8_LAS bf16x8*)(lds + PG8_SB(b, h) + boff + n * 2048 + k * 1024); } while (0)
#define PG8_MMA(ai, bj, At, Bt) do { __builtin_amdgcn_s_setprio(1); _Pragma("unroll") for (int m = 0; m < 4; ++m) _Pragma("unroll") for (int n = 0; n < 2; ++n) _Pragma("unroll") for (int k = 0; k < 2; ++k) \
        acc[ai][bj][m][n] = __builtin_amdgcn_mfma_f32_16x16x32_bf16(Bt[n][k], At[m][k], acc[ai][bj][m][n], 0, 0, 0); __builtin_amdgcn_s_setprio(0); } while (0)
#define PG8_WAIT_V(n) asm volatile("s_waitcnt vmcnt(" #n ")" ::: "memory")
#define PG8_WAIT_L(n) asm volatile("s_waitcnt lgkmcnt(" #n ")" ::: "memory")
#define PG8_BAR __builtin_amdgcn_s_barrier()
#define PG8_SCHED __builtin_amdgcn_sched_barrier(0)
    Unit cur, nxt; int ui = 0;
    if (!S.next(0, cur)) return;
    f32x4 acc[2][2][4][2];
    if constexpr (Epi::AFTER_DRAIN) E.init(acc, cur, wr, wc, fr, fq);
    else {
#pragma unroll
    for (int a = 0; a < 2; ++a)
#pragma unroll
        for (int b = 0; b < 2; ++b)
#pragma unroll
            for (int m = 0; m < 4; ++m)
#pragma unroll
                for (int n = 0; n < 2; ++n) acc[a][b][m][n] = (f32x4){0.f, 0.f, 0.f, 0.f};
    }
    bf16x8 At[4][2], B0[2][2], B1[2][2];
    const char* cA = (const char*)g.A + (size_t)cur.pm * tstep; const char* cB = (const char*)g.Bt + (size_t)cur.pn * tstep;
    S.a_ready(cur);
    if constexpr (SP2) {
        PG8_STAGE(PG8_SB(0, 0), cB, voffB); PG8_STAGE(PG8_SB(0, 1), cB + hstep, voffB); PG8_STAGE(PG8_SA(0, 0), cA, voffA); PG8_STAGE(PG8_SA(0, 1), cA + hstep, voffA);
        E.prefill(tid);
        if (wr == 1) PG8_BAR;
        PG8_WAIT_V(2); PG8_BAR;
        PG8_STAGE(PG8_SB(1, 0), cB + kstep, voffB); PG8_STAGE(PG8_SA(1, 0), cA + kstep, voffA); PG8_STAGE(PG8_SB(1, 1), cB + hstep + kstep, voffB);
        PG8_WAIT_V(6); PG8_BAR;
    } else {
        PG8_STAGE(PG8_SB(0, 0), cB, voffB); PG8_STAGE(PG8_SA(0, 0), cA, voffA); PG8_STAGE(PG8_SB(0, 1), cB + hstep, voffB); PG8_STAGE(PG8_SA(0, 1), cA + hstep, voffA);
        E.prefill(tid);
        if (wr == 1) PG8_BAR;
        PG8_WAIT_V(4); PG8_BAR;
        PG8_STAGE(PG8_SB(1, 0), cB + kstep, voffB); PG8_STAGE(PG8_SA(1, 0), cA + kstep, voffA); PG8_STAGE(PG8_SB(1, 1), cB + hstep + kstep, voffB);
        PG8_WAIT_V(6); PG8_BAR;
    }
    for (;;) {
        const bool has_next = S.next(ui + 1, nxt);
        const char* nA = has_next ? (const char*)g.A + (size_t)nxt.pm * tstep : cA; const char* nB = has_next ? (const char*)g.Bt + (size_t)nxt.pn * tstep : cB;
        for (int t = 0; t < nt; t += 2) {
            const bool last = (t == nt - 2);
            const char* a1 = cA + (size_t)(t + 1) * kstep;
            const char* a2 = last ? nA : cA + (size_t)(t + 2) * kstep; const char* b2 = last ? nB : cB + (size_t)(t + 2) * kstep;
            const char* a3 = a2 + kstep; const char* b3 = b2 + kstep;
            if (last && has_next) S.a_ready(nxt);
            if constexpr (SP2) {
            PG8_LDB(B0, 0, 0); PG8_LDB(B1, 0, 1); PG8_SCHED; PG8_LDA(At, 0, 0); PG8_STAGE(PG8_SA(1, 1), a1 + hstep, voffA);
            PG8_WAIT_V(8); PG8_WAIT_L(0); PG8_BAR; PG8_MMA(0, 0, At, B0); PG8_MMA(0, 1, At, B1); PG8_BAR; PG8_SCHED;
            PG8_LDA(At, 0, 1); PG8_STAGE(PG8_SB(0, 0), b2, voffB); PG8_STAGE(PG8_SB(0, 1), b2 + hstep, voffB); PG8_STAGE(PG8_SA(0, 0), a2, voffA);
            PG8_WAIT_V(8); PG8_WAIT_L(0); PG8_BAR; PG8_MMA(1, 0, At, B0); PG8_MMA(1, 1, At, B1); PG8_BAR; PG8_SCHED;
            PG8_LDB(B0, 1, 0); PG8_LDB(B1, 1, 1); PG8_SCHED; PG8_LDA(At, 1, 0); PG8_STAGE(PG8_SA(0, 1), a2 + hstep, voffA);
            PG8_WAIT_V(8); PG8_WAIT_L(0); PG8_BAR; PG8_MMA(0, 0, At, B0); PG8_MMA(0, 1, At, B1); PG8_BAR; PG8_SCHED;
            PG8_LDA(At, 1, 1); PG8_STAGE(PG8_SB(1, 0), b3, voffB); PG8_STAGE(PG8_SB(1, 1), b3 + hstep, voffB); PG8_STAGE(PG8_SA(1, 0), a3, voffA);
            PG8_WAIT_V(8); PG8_WAIT_L(0); PG8_BAR; PG8_MMA(1, 0, At, B0); PG8_MMA(1, 1, At, B1); PG8_BAR; PG8_SCHED;
            } else {
            PG8_LDB(B0, 0, 0); PG8_SCHED; PG8_LDA(At, 0, 0); PG8_STAGE(PG8_SA(1, 1), a1 + hstep, voffA);
            PG8_WAIT_L(8); PG8_BAR; PG8_WAIT_L(0); PG8_MMA(0, 0, At, B0); PG8_BAR; PG8_SCHED;
            PG8_LDB(B1, 0, 1); PG8_STAGE(PG8_SB(0, 0), b2, voffB);
            PG8_BAR; PG8_WAIT_L(0); PG8_MMA(0, 1, At, B1); PG8_BAR;
            PG8_LDA(At, 0, 1); PG8_STAGE(PG8_SA(0, 0), a2, voffA);
            PG8_BAR; PG8_WAIT_L(0); PG8_MMA(1, 0, At, B0); PG8_BAR; PG8_SCHED;
            PG8_STAGE(PG8_SB(0, 1), b2 + hstep, voffB);
            PG8_WAIT_V(6); PG8_BAR; PG8_MMA(1, 1, At, B1); PG8_BAR;
            PG8_LDB(B0, 1, 0); PG8_SCHED; PG8_LDA(At, 1, 0); PG8_STAGE(PG8_SA(0, 1), a2 + hstep, voffA);
            PG8_WAIT_L(8); PG8_BAR; PG8_WAIT_L(0); PG8_MMA(0, 0, At, B0); PG8_BAR; PG8_SCHED;
            PG8_LDB(B1, 1, 1); PG8_STAGE(PG8_SB(1, 0), b3, voffB);
            PG8_BAR; PG8_WAIT_L(0); PG8_MMA(0, 1, At, B1); PG8_BAR;
            PG8_LDA(At, 1, 1); PG8_STAGE(PG8_SA(1, 0), a3, voffA);
            PG8_BAR; PG8_WAIT_L(0); PG8_MMA(1, 0, At, B0); PG8_BAR; PG8_SCHED;
            PG8_STAGE(PG8_SB(1, 1), b3 + hstep, voffB);
            PG8_WAIT_V(6); PG8_BAR; PG8_MMA(1, 1, At, B1); PG8_BAR;
            }
        }
        if constexpr (ALIGN_EPI) { if (wr == 0) PG8_BAR; }
        if constexpr (!Epi::AFTER_DRAIN) { E(acc, cur, wr, wc, fr, fq); S.done(cur); }
        if (!has_next) break;
#pragma unroll
        for (int a = 0; a < 2; ++a)
#pragma unroll
            for (int b = 0; b < 2; ++b)
#pragma unroll
                for (int m = 0; m < 4; ++m)
#pragma unroll
                    for (int n = 0; n < 2; ++n) acc[a][b][m][n] = (f32x4){0.f, 0.f, 0.f, 0.f};
        cur = nxt; cA = nA; cB = nB; ++ui;
        if constexpr (ALIGN_EPI) { if (wr == 1) PG8_BAR; }
    }
    PG8_WAIT_V(0);
    if constexpr (!ALIGN_EPI) { if (wr == 0) PG8_BAR; }
    PG8_BAR;
    if constexpr (Epi::AFTER_DRAIN) { E.fused(acc, cur, wr, wc, fr, fq, lds, wid, lane); S.done(cur); }
#undef PG8_SA
#undef PG8_SB
#undef PG8_STAGE
#undef PG8_LDA
#undef PG8_LDB
#undef PG8_MMA
#undef PG8_WAIT_V
#undef PG8_WAIT_L
#undef PG8_BAR
#undef PG8_SCHED
}
}
#ifndef PG8_SP2
#define PG8_SP2 true
#endif
#ifndef PG8_ALIGN
#define PG8_ALIGN true
#endif
#define GAS __attribute__((address_space(1)))
#define LAS __attribute__((address_space(3)))
typedef unsigned short bf16;
typedef unsigned v4u __attribute__((ext_vector_type(4)));
typedef unsigned v2u __attribute__((ext_vector_type(2)));
typedef float f32x4 __attribute__((ext_vector_type(4)));
typedef float f32x2 __attribute__((ext_vector_type(2)));
typedef short bf16x8 __attribute__((ext_vector_type(8)));
#define LDS_WAIT() asm volatile("s_waitcnt lgkmcnt(0)" ::: "memory")

constexpr int DM = 2048, MROWS = 8192, SEQ = 2048, FFH = 5632, NAB = 6144, NC = 4096, NGU = 2 * FFH;
constexpr float EPS = 1e-6f;
constexpr int NWAVES = 8, NTHREADS = 512, LDS_BYTES = 155648;
constexpr size_t MiB = 1u << 20;
constexpr size_t WS_CTL = 0, CTL_ZERO_BYTES = 1 * MiB;
constexpr size_t WS_STATS = 1 * MiB;
constexpr size_t WS_LNP = 2 * MiB;
constexpr size_t WS_WAB_IN = 4 * MiB;
constexpr size_t WS_WAB_OUT = WS_WAB_IN + 48 * MiB;
constexpr size_t WS_WC_IN = WS_WAB_OUT + 16 * MiB;
constexpr size_t WS_WC_OUT = WS_WC_IN + 32 * MiB;
constexpr size_t WS_WGU = WS_WC_OUT + 16 * MiB;
constexpr size_t WS_WD = WS_WGU + 176 * MiB;
constexpr size_t WS_XB = WS_WD + 88 * MiB;
constexpr size_t WS_CAT = WS_XB + 32 * MiB;
constexpr size_t WS_PROJ = WS_CAT + 32 * MiB;
constexpr size_t WS_HID = WS_PROJ + 96 * MiB;
constexpr size_t WS_END = WS_HID + 88 * MiB;

__device__ __forceinline__ float bf_lo(unsigned w) { return __uint_as_float(w << 16); }
__device__ __forceinline__ float bf_hi(unsigned w) { return __uint_as_float(w & 0xffff0000u); }
__device__ __forceinline__ unsigned pk2(float lo, float hi) { return pg8::cvt_pk_bf16(lo, hi); }
__device__ __forceinline__ float wave_sum(float v) {
#pragma unroll
    for (int o = 1; o < 64; o <<= 1) v += __shfl_xor(v, o);
    return v;
}
__device__ __forceinline__ float wave_max(float v) {
#pragma unroll
    for (int o = 1; o < 64; o <<= 1) v = fmaxf(v, __shfl_xor(v, o));
    return v;
}

#ifndef CVT_2D
#define CVT_2D 0
#endif
struct CvtD { const float* W; const float* g; bf16* WT; int K, N, k0, n0, drow0; };
struct CvtV { f32x4 v[16]; float gv; };
__device__ __forceinline__ void cvt_desc(CvtD& d, const float* W, int K, int N, bf16* WT, const float* g, int mode, int item) {
#if CVT_2D
    const int nblk2 = N >> 7, grp = item >> 3, w8 = item & 7, kbg = grp / nblk2, nbg = grp - kbg * nblk2, kb = 4 * kbg + (w8 >> 1), nb = 2 * nbg + (w8 & 1);
#else
    const int nblk = N >> 6, kb = item / nblk, nb = item - kb * nblk;
#endif
    d.W = W; d.g = g; d.WT = WT; d.K = K; d.N = N; d.k0 = kb << 6; d.n0 = nb << 6;
    d.drow0 = mode == 0 ? d.n0 : ((d.n0 >> 7) * 256 + (d.n0 & 127) + (mode == 2 ? 128 : 0));
}
__device__ __forceinline__ void cvt_load(const CvtD& d, CvtV& r, int lane) {
    const int c4 = (lane & 15) * 4, kq = lane >> 4;
    r.gv = d.g ? d.g[d.k0 + lane] : 1.0f;
#pragma unroll
    for (int i = 0; i < 16; ++i) r.v[i] = *(const f32x4*)(d.W + (size_t)(d.k0 + 4 * i + kq) * d.N + d.n0 + c4);
}
__device__ __forceinline__ void cvt_finish(const CvtD& d, const CvtV& r, LAS float* scr, int lane) {
    const int c4 = (lane & 15) * 4, kq = lane >> 4;
#pragma unroll
    for (int i = 0; i < 16; ++i) { const int kk = 4 * i + kq; const float gg = __shfl(r.gv, kk); LAS float* s = scr + kk * 65 + c4;
        s[0] = r.v[i][0] * gg; s[1] = r.v[i][1] * gg; s[2] = r.v[i][2] * gg; s[3] = r.v[i][3] * gg; }
    LDS_WAIT(); asm volatile("" ::: "memory");
    const int c = lane & 7;
#pragma unroll
    for (int p = 0; p < 8; ++p) { const int n = (lane >> 3) + 8 * p; const LAS float* s = scr + (8 * c) * 65 + n;
        v4u o; o.x = pk2(s[0 * 65], s[1 * 65]); o.y = pk2(s[2 * 65], s[3 * 65]); o.z = pk2(s[4 * 65], s[5 * 65]); o.w = pk2(s[6 * 65], s[7 * 65]);
        *(v4u*)(d.WT + (size_t)(d.drow0 + n) * d.K + d.k0 + 8 * c) = o; }
    LDS_WAIT(); asm volatile("" ::: "memory");
}

struct Args { const float* in[17]; float* out; unsigned char* ws; int ph_lo, ph_hi; };
constexpr int TBL_OFF = LDS_BYTES - 256, RSTAB_OFF = 131072;
__device__ __forceinline__ unsigned tbl_u32(LAS unsigned char* lds, int w) { return (unsigned)__builtin_amdgcn_readfirstlane((int)((volatile LAS unsigned*)(lds + TBL_OFF))[w]); }
__device__ __forceinline__ const float* tbl_ptr(LAS unsigned char* lds, int k) { const unsigned lo = tbl_u32(lds, 2 * k), hi = tbl_u32(lds, 2 * k + 1); return (const float*)(((unsigned long long)hi << 32) | lo); }
__device__ __forceinline__ const float* tbl_ptr_g(LAS unsigned char* lds, int k) { const unsigned lo = tbl_u32(lds, 2 * k), hi = tbl_u32(lds, 2 * k + 1); return (const float*)(GAS const float*)(((unsigned long long)hi << 32) | lo); }
#define IN_(k) tbl_ptr(lds, (k))
#define OUT_() ((float*)tbl_ptr(lds, 17))
#define WS_() ((unsigned char*)tbl_ptr(lds, 18))
#define WS_G() ((unsigned char*)tbl_ptr_g(lds, 18))
#define OUT_G() ((float*)tbl_ptr_g(lds, 17))
#define IN_G(k) tbl_ptr_g(lds, (k))

#ifndef CVT_TAIL
#define CVT_TAIL 6144
#endif
constexpr int I_ABIN = 32 * 96, I_SQ = 32 * 32, I_CIN = 32 * 64, I_FF = 32 * 88;
__host__ __device__ constexpr int cvt_layer_items(int L) { return ((L & 1) ? I_CIN : I_ABIN) + I_SQ + 3 * I_FF; }
__device__ __forceinline__ void cvt_layer_desc(CvtD& d, LAS unsigned char* lds, int L, int j) {
    unsigned char* ws = WS_G();
    const int i = L >> 1; const bool even = (L & 1) == 0; const int n_in = even ? I_ABIN : I_CIN;
    if (j < n_in) {
        if (even) cvt_desc(d, IN_G(2) + (size_t)i * DM * NAB, DM, NAB, (bf16*)(ws + WS_WAB_IN) + (size_t)i * NAB * DM, IN_G(1) + (size_t)L * DM, 0, j);
        else cvt_desc(d, IN_G(6) + (size_t)i * DM * NC, DM, NC, (bf16*)(ws + WS_WC_IN) + (size_t)i * NC * DM, IN_G(1) + (size_t)L * DM, 0, j);
        return; }
    j -= n_in;
    if (j < I_SQ) {
        if (even) cvt_desc(d, IN_G(5) + (size_t)i * DM * DM, DM, DM, (bf16*)(ws + WS_WAB_OUT) + (size_t)i * DM * DM, nullptr, 0, j);
        else cvt_desc(d, IN_G(11) + (size_t)i * DM * DM, DM, DM, (bf16*)(ws + WS_WC_OUT) + (size_t)i * DM * DM, nullptr, 0, j);
        return; }
    j -= I_SQ;
    if (j < I_FF) { cvt_desc(d, IN_G(13) + (size_t)L * DM * FFH, DM, FFH, (bf16*)(ws + WS_WGU) + (size_t)L * NGU * DM, IN_G(12) + (size_t)L * DM, 1, j); return; }
    j -= I_FF;
    if (j < I_FF) { cvt_desc(d, IN_G(14) + (size_t)L * DM * FFH, DM, FFH, (bf16*)(ws + WS_WGU) + (size_t)L * NGU * DM, IN_G(12) + (size_t)L * DM, 2, j); return; }
    j -= I_FF;
    cvt_desc(d, IN_G(15) + (size_t)L * FFH * DM, FFH, DM, (bf16*)(ws + WS_WD) + (size_t)L * DM * FFH, nullptr, 0, j);
}
__device__ __forceinline__ void pro_desc(CvtD& d, LAS unsigned char* lds, int it) {
    constexpr int P0 = cvt_layer_items(0), P1 = cvt_layer_items(1) - CVT_TAIL, P2 = cvt_layer_items(2) - CVT_TAIL;
    int r = it, L = 0;
    if (r >= P0) { r -= P0; L = 1; if (r >= P1) { r -= P1; L = 2; if (r >= P2) { r -= P2; L = 3; } } }
    cvt_layer_desc(d, lds, L, r);
}
__device__ __forceinline__ void prologue_phase(LAS unsigned char* lds, int gw, int NGW, int wave, int lane) {
    LAS float* scr = (LAS float*)(lds + wave * 16640);
    constexpr int PTOT = cvt_layer_items(0) + cvt_layer_items(1) + cvt_layer_items(2) + cvt_layer_items(3) - 3 * CVT_TAIL;
    {
        CvtD dA, dB; CvtV vA, vB; int it = gw;
        if (it < PTOT) { pro_desc(dA, lds, it); cvt_load(dA, vA, lane); }
        while (it < PTOT) {
            const int itB = it + NGW; const bool hasB = itB < PTOT;
            if (hasB) { pro_desc(dB, lds, itB); cvt_load(dB, vB, lane); }
            cvt_finish(dA, vA, scr, lane);
            if (!hasB) break;
            const int itA = itB + NGW; const bool hasA = itA < PTOT;
            if (hasA) { pro_desc(dA, lds, itA); cvt_load(dA, vA, lane); }
            cvt_finish(dB, vB, scr, lane);
            it = itA;
        }
    }
    unsigned char* ws = WS_G();
    const float* x = IN_G(0); bf16* xb = (bf16*)(ws + WS_XB); float* stats = (float*)(ws + WS_STATS);
    for (int m = gw; m < MROWS; m += NGW) {
        const f32x4* xr = (const f32x4*)(x + (size_t)m * DM) + 2 * lane; f32x4 v[8]; float s = 0.f;
#pragma unroll
        for (int j = 0; j < 4; ++j) { v[2 * j] = xr[128 * j]; v[2 * j + 1] = xr[128 * j + 1]; }
#pragma unroll
        for (int j = 0; j < 8; ++j) s += (v[j][0] * v[j][0] + v[j][1] * v[j][1]) + (v[j][2] * v[j][2] + v[j][3] * v[j][3]);
        s = wave_sum(s);
        v4u* o16 = (v4u*)(xb + (size_t)m * DM) + lane;
#pragma unroll
        for (int j = 0; j < 4; ++j) { v4u w; w.x = pk2(v[2 * j][0], v[2 * j][1]); w.y = pk2(v[2 * j][2], v[2 * j][3]); w.z = pk2(v[2 * j + 1][0], v[2 * j + 1][1]); w.w = pk2(v[2 * j + 1][2], v[2 * j + 1][3]); o16[64 * j] = w; }
        if (lane < 8) stats[(size_t)m * 8 + lane] = lane == 0 ? s : 0.f;
    }
}
__device__ __forceinline__ void cvt_tail(LAS unsigned char* lds, int L, int cu, int wave, int lane) {
    LAS float* scr = (LAS float*)(lds + wave * 16640);
    const int cnt = cvt_layer_items(L);
    CvtD dA, dB; CvtV vA, vB; int j = cnt - CVT_TAIL + (cu - 128) * NWAVES + wave; const int st = 128 * NWAVES;
    if (j < cnt) { cvt_layer_desc(dA, lds, L, j); cvt_load(dA, vA, lane); }
    while (j < cnt) {
        const int jB = j + st; const bool hasB = jB < cnt;
        if (hasB) { cvt_layer_desc(dB, lds, L, jB); cvt_load(dB, vB, lane); }
        cvt_finish(dA, vA, scr, lane);
        if (!hasB) break;
        const int jA = jB + st; const bool hasA = jA < cnt;
        if (hasA) { cvt_layer_desc(dA, lds, L, jA); cvt_load(dA, vA, lane); }
        cvt_finish(dB, vB, scr, lane);
        j = jA;
    }
}

__device__ __forceinline__ void final_phase(float* out, const bf16* xb, const float* stats, const float* g, int gw, int NGW, int lane) {
    f32x4 gg[8];
#pragma unroll
    for (int j = 0; j < 4; ++j) { gg[2 * j] = ((const f32x4*)g)[2 * (lane + 64 * j)]; gg[2 * j + 1] = ((const f32x4*)g)[2 * (lane + 64 * j) + 1]; }
    for (int m0 = gw; m0 < MROWS; m0 += 4 * NGW) {
        v4u xw[4][4]; float rs[4];
#pragma unroll
        for (int r = 0; r < 4; ++r) { const int m = m0 + r * NGW; if (m < MROWS) { rs[r] = pg8::row_rs(stats, m); const v4u* xr = (const v4u*)(xb + (size_t)m * DM) + lane;
#pragma unroll
            for (int j = 0; j < 4; ++j) xw[r][j] = xr[64 * j]; } }
#pragma unroll
        for (int r = 0; r < 4; ++r) { const int m = m0 + r * NGW; if (m < MROWS) { f32x4* orow = (f32x4*)(out + (size_t)m * DM);
#pragma unroll
            for (int j = 0; j < 4; ++j) { const v4u w = xw[r][j]; const int c4 = 2 * (lane + 64 * j);
                const f32x4 a = (f32x4){bf_lo(w.x), bf_hi(w.x), bf_lo(w.y), bf_hi(w.y)}, b = (f32x4){bf_lo(w.z), bf_hi(w.z), bf_lo(w.w), bf_hi(w.w)};
                orow[c4] = a * rs[r] * gg[2 * j]; orow[c4 + 1] = b * rs[r] * gg[2 * j + 1]; } } }
    }
}

constexpr int A_TILE = 16384, A_BUF = 2 * A_TILE, A_LT_OFF = 2 * A_BUF, A_LT_BYTES = 10 * 8192;
static_assert(A_LT_OFF + A_LT_BYTES + 2304 <= LDS_BYTES - 256, "attention LDS map");
typedef float f32x16 __attribute__((ext_vector_type(16)));
typedef short s16x4 __attribute__((ext_vector_type(4)));
__device__ __forceinline__ s16x4 lds_tr16(const LAS unsigned char* p) { return __builtin_bit_cast(s16x4, __builtin_amdgcn_ds_read_tr16_b64_v4i16((LAS s16x4*)p)); }
__device__ __forceinline__ float xhalf_max(float v) { auto rr = __builtin_amdgcn_permlane32_swap(__float_as_uint(v), __float_as_uint(v), false, false); return fmaxf(__uint_as_float(rr[0]), __uint_as_float(rr[1])); }
__device__ __forceinline__ float xhalf_sum(float v) { auto rr = __builtin_amdgcn_permlane32_swap(__float_as_uint(v), __float_as_uint(v), false, false); return __uint_as_float(rr[0]) + __uint_as_float(rr[1]); }
#define A_MX3(a, b, c) __builtin_fmaxf(__builtin_fmaxf((a), (b)), (c))
__device__ __forceinline__ void attn_phase(const bf16* PROJ, bf16* CAT, const float* relb, LAS unsigned char* lds, int cu, int G, int tid, int wave, int lane) {
    const float C2 = 0.08838834764831845f * 1.4426950408889634f, ISC = 11.313708498984761f;
    const int q32 = lane & 31, hh = lane >> 5;
    const int drow = lane >> 4, dpos = lane & 15;
    const int koff0 = q32 * 256, koff1 = (32 + q32) * 256, kx = q32 & 15;
    const int g4 = lane >> 4, tq = (lane & 15) >> 2, tp = lane & 3;
    const int vrow = 4 * (g4 >> 1) + tq, vlow = 2 * (g4 & 1) + (tp >> 1), vin = 8 * (tp & 1);
    for (int unit = cu; unit < 256; unit += G) {
        const int bh = (unit & 7) | ((unit >> 6) << 3), qc4 = (unit >> 3) & 7, b = bh >> 3, h = bh & 7;
        const int row0 = b * SEQ + qc4 * 256;
        asm volatile("s_waitcnt vmcnt(0) lgkmcnt(0)" ::: "memory"); __builtin_amdgcn_s_barrier(); asm volatile("" ::: "memory");
        { LAS float* LT = (LAS float*)(lds + A_LT_OFF); LAS float* rb = (LAS float*)(lds + A_LT_OFF + A_LT_BYTES);
          for (int x = tid; x < 513; x += NTHREADS) rb[x] = relb[h * 513 + x];
          asm volatile("s_waitcnt lgkmcnt(0)" ::: "memory"); __builtin_amdgcn_s_barrier(); asm volatile("" ::: "memory");
          for (int x0 = tid; x0 < 10 * 2048; x0 += 8 * NTHREADS) {
              float tv[8];
#pragma unroll
              for (int k = 0; k < 8; ++k) { const int x = x0 + k * NTHREADS, e = x >> 11, rem = x & 2047, rq = rem >> 8, ln = (rem & 255) >> 2, c = rem & 3, r = 4 * rq + c;
                  const int kj = (r & 3) + 8 * ((r & 15) >> 2) + 4 * (ln >> 5) + 32 * (r >> 4); int idx = 32 * e + (ln & 31) + 256 - kj; idx = idx > 512 ? 512 : idx;
                  tv[k] = rb[idx]; }
#pragma unroll
              for (int k = 0; k < 8; ++k) LT[x0 + k * NTHREADS] = tv[k] * ISC; } }
        float bcs = relb[h * 513 + 512] * ISC;
        bf16x8 qf[8];
        { const bf16* qp = PROJ + (size_t)(row0 + 32 * wave + q32) * NAB + h * 128 + 8 * hh;
#pragma unroll
          for (int ds = 0; ds < 8; ++ds) qf[ds] = *(const bf16x8*)(qp + 16 * ds); }
        asm volatile("s_waitcnt vmcnt(0)" ::: "memory");
#pragma unroll
        for (int ds = 0; ds < 8; ++ds) asm volatile("" : "+v"(qf[ds]));
        asm volatile("" : "+v"(bcs));
        const int t0 = qc4 >= 2 ? 0 : 8 - 4 * qc4;
        const int wlo = wave >> 1, whi = wlo + 8;
        const int r0 = 4 * wave + drow, r1 = r0 + 32;
        const bf16* tile0 = PROJ + ((long)(b * SEQ + (4 * qc4 - 8) * 64)) * NAB + 1024 + h * 128;
        const bf16* gk0 = tile0 + (long)r0 * NAB + ((dpos ^ (r0 & 15)) << 3);
        const bf16* gk1 = tile0 + (long)r1 * NAB + ((dpos ^ (r1 & 15)) << 3);
        const bf16* gv0 = tile0 + (long)r0 * NAB + 1024 + ((dpos ^ ((r0 & 3) << 2)) << 3);
        const bf16* gv1 = tile0 + (long)r1 * NAB + 1024 + ((dpos ^ ((r1 & 3) << 2)) << 3);
#define A_DMA(t) do { const long go_ = (long)(t) * 64 * NAB; LAS unsigned char* d_ = lds + ((t) & 1) * A_BUF + wave * 1024; \
            __builtin_amdgcn_global_load_lds((const unsigned*)(gk0 + go_), (LAS unsigned*)(d_), 16, 0, 0); \
            __builtin_amdgcn_global_load_lds((const unsigned*)(gk1 + go_), (LAS unsigned*)(d_ + 8192), 16, 0, 0); \
            __builtin_amdgcn_global_load_lds((const unsigned*)(gv0 + go_), (LAS unsigned*)(d_ + A_TILE), 16, 0, 0); \
            __builtin_amdgcn_global_load_lds((const unsigned*)(gv1 + go_), (LAS unsigned*)(d_ + A_TILE + 8192), 16, 0, 0); } while (0)
        A_DMA(t0);
        float mx = -1e30f, lsum = 0.f;
        f32x16 o[4];
#pragma unroll
        for (int db = 0; db < 4; ++db)
#pragma unroll
            for (int r = 0; r < 16; ++r) o[db][r] = 0.f;
        for (int t = t0; t < 12; ++t) {
            asm volatile("s_waitcnt vmcnt(0) lgkmcnt(0)" ::: "memory"); __builtin_amdgcn_s_barrier(); asm volatile("" ::: "memory");
            if (t + 1 < 12) A_DMA(t + 1);
            if (t >= wlo && t <= whi) {
                const LAS unsigned char* Kb = lds + (t & 1) * A_BUF; const LAS unsigned char* Vb = Kb + A_TILE;
                const int dn = wlo + 8 - t;
                bf16x8 kf[16];
#pragma unroll
                for (int ds = 0; ds < 8; ++ds) { const int cp = ((2 * ds + hh) ^ kx) << 4; kf[2 * ds] = *(const LAS bf16x8*)(Kb + koff0 + cp); kf[2 * ds + 1] = *(const LAS bf16x8*)(Kb + koff1 + cp); }
                f32x16 p0, p1;
                if (dn >= 5) {
#pragma unroll
                    for (int r = 0; r < 16; ++r) { p0[r] = bcs; p1[r] = bcs; }
                } else { const LAS unsigned char* lt = lds + A_LT_OFF + (2 * dn + (wave & 1)) * 8192 + lane * 16;
#pragma unroll
                    for (int rq = 0; rq < 4; ++rq) { const f32x4 a = *(const LAS f32x4*)(lt + rq * 1024), c = *(const LAS f32x4*)(lt + (rq + 4) * 1024);
                        p0[4 * rq] = a[0]; p0[4 * rq + 1] = a[1]; p0[4 * rq + 2] = a[2]; p0[4 * rq + 3] = a[3]; p1[4 * rq] = c[0]; p1[4 * rq + 1] = c[1]; p1[4 * rq + 2] = c[2]; p1[4 * rq + 3] = c[3]; }
                }
                asm volatile("s_waitcnt lgkmcnt(0)" ::: "memory"); __builtin_amdgcn_sched_barrier(0);
#pragma unroll
                for (int ds = 0; ds < 8; ++ds) {
                    p0 = __builtin_amdgcn_mfma_f32_32x32x16_bf16(kf[2 * ds], qf[ds], p0, 0, 0, 0);
                    p1 = __builtin_amdgcn_mfma_f32_32x32x16_bf16(kf[2 * ds + 1], qf[ds], p1, 0, 0, 0);
                }
                __builtin_amdgcn_sched_barrier(0);
                s16x4 vlo[4][4], vhi[4][4];
#pragma unroll
                for (int db = 0; db < 4; ++db) {
                    const LAS unsigned char* vp = Vb + vrow * 256 + ((((db ^ tq) << 2) + vlow) << 4) + vin;
                    const unsigned va = (unsigned)(uintptr_t)vp;
#pragma unroll
                    for (int ks = 0; ks < 4; ++ks) {
                        asm volatile("ds_read_b64_tr_b16 %0, %1 offset:%c2" : "=&v"(vlo[db][ks]) : "v"(va), "i"((16 * ks) * 256) : "memory");
                        asm volatile("ds_read_b64_tr_b16 %0, %1 offset:%c2" : "=&v"(vhi[db][ks]) : "v"(va), "i"((16 * ks + 8) * 256) : "memory"); }
                }
                __builtin_amdgcn_sched_barrier(0);
                float ta = A_MX3(p0[0], p0[1], p1[0]), tb = A_MX3(p0[2], p0[3], p1[1]); ta = A_MX3(ta, p1[2], p1[3]);
#pragma unroll
                for (int r = 4; r < 16; r += 4) { ta = A_MX3(ta, p0[r], p0[r + 1]); tb = A_MX3(tb, p0[r + 2], p0[r + 3]); ta = A_MX3(ta, p1[r], p1[r + 1]); tb = A_MX3(tb, p1[r + 2], p1[r + 3]); }
                const float tm = xhalf_max(fmaxf(ta, tb));
                if (__any(tm > mx)) {
                    const float mn = fmaxf(mx, tm), alpha = __builtin_amdgcn_exp2f((mx - mn) * C2); mx = mn; lsum *= alpha;
#pragma unroll
                    for (int db = 0; db < 4; ++db)
#pragma unroll
                        for (int r = 0; r < 16; ++r) o[db][r] *= alpha;
                }
                const float nm = -mx * C2;
                float rsum = 0.f;
#pragma unroll
                for (int r = 0; r < 16; ++r) { p0[r] = __builtin_amdgcn_exp2f(__builtin_fmaf(p0[r], C2, nm)); p1[r] = __builtin_amdgcn_exp2f(__builtin_fmaf(p1[r], C2, nm)); rsum += p0[r] + p1[r]; }
                lsum += rsum;
                bf16x8 pf[4];
#pragma unroll
                for (int s2 = 0; s2 < 2; ++s2) {
                    v4u a, c;
                    a.x = pk2(p0[8 * s2 + 0], p0[8 * s2 + 1]); a.y = pk2(p0[8 * s2 + 2], p0[8 * s2 + 3]); a.z = pk2(p0[8 * s2 + 4], p0[8 * s2 + 5]); a.w = pk2(p0[8 * s2 + 6], p0[8 * s2 + 7]);
                    c.x = pk2(p1[8 * s2 + 0], p1[8 * s2 + 1]); c.y = pk2(p1[8 * s2 + 2], p1[8 * s2 + 3]); c.z = pk2(p1[8 * s2 + 4], p1[8 * s2 + 5]); c.w = pk2(p1[8 * s2 + 6], p1[8 * s2 + 7]);
                    pf[s2] = __builtin_bit_cast(bf16x8, a); pf[2 + s2] = __builtin_bit_cast(bf16x8, c);
                }
                asm volatile("s_waitcnt lgkmcnt(0)" ::: "memory"); __builtin_amdgcn_sched_barrier(0);
#pragma unroll
                for (int ks = 0; ks < 4; ++ks)
#pragma unroll
                    for (int db = 0; db < 4; ++db) {
                        const s16x4 lo = vlo[db][ks], hi = vhi[db][ks];
                        const bf16x8 vf = (bf16x8){lo[0], lo[1], lo[2], lo[3], hi[0], hi[1], hi[2], hi[3]};
                        o[db] = __builtin_amdgcn_mfma_f32_32x32x16_bf16(vf, pf[ks], o[db], 0, 0, 0);
                    }
                __builtin_amdgcn_sched_barrier(0);
            }
        }
#undef A_DMA
        const float inv = 1.0f / xhalf_sum(lsum);
        bf16* op = CAT + (size_t)(row0 + 32 * wave + q32) * DM + h * 128 + 8 * hh;
#pragma unroll
        for (int db = 0; db < 4; ++db)
#pragma unroll
            for (int rq = 0; rq < 4; rq += 2) {
                unsigned ax = pk2(o[db][4 * rq] * inv, o[db][4 * rq + 1] * inv), ay = pk2(o[db][4 * rq + 2] * inv, o[db][4 * rq + 3] * inv);
                unsigned bx = pk2(o[db][4 * rq + 4] * inv, o[db][4 * rq + 5] * inv), by = pk2(o[db][4 * rq + 6] * inv, o[db][4 * rq + 7] * inv);
                { auto r = __builtin_amdgcn_permlane32_swap(ax, bx, false, false); ax = r[0]; bx = r[1]; }
                { auto r = __builtin_amdgcn_permlane32_swap(ay, by, false, false); ay = r[0]; by = r[1]; }
                v4u w; w.x = ax; w.y = ay; w.z = bx; w.w = by;
                *(v4u*)(op + 32 * db + 8 * rq) = w; }
    }
    asm volatile("s_waitcnt vmcnt(0) lgkmcnt(0)" ::: "memory"); __builtin_amdgcn_s_barrier(); asm volatile("" ::: "memory");
}

__device__ __forceinline__ void conv_unpack_mul(const v4u a, const v4u b, float (&z)[8]) {
    z[0] = bf_lo(a.x) * bf_lo(b.x); z[1] = bf_hi(a.x) * bf_hi(b.x); z[2] = bf_lo(a.y) * bf_lo(b.y); z[3] = bf_hi(a.y) * bf_hi(b.y);
    z[4] = bf_lo(a.z) * bf_lo(b.z); z[5] = bf_hi(a.z) * bf_hi(b.z); z[6] = bf_lo(a.w) * bf_lo(b.w); z[7] = bf_hi(a.w) * bf_hi(b.w);
}
__device__ __forceinline__ void conv_phase(const bf16* PROJ, bf16* CAT, const float* cw  , int gtid, int nthr) {
    for (int idx = gtid; idx < (MROWS / 8) * 128; idx += nthr) {
        const int c8 = (idx & 127) * 8, r0 = (idx >> 7) * 8, t0 = r0 & 2047;
        float w[3][8];
#pragma unroll
        for (int j = 0; j < 3; ++j) { const f32x4 a = *(const f32x4*)(cw + j * 1024 + c8), b = *(const f32x4*)(cw + j * 1024 + c8 + 4);
            w[j][0] = a[0]; w[j][1] = a[1]; w[j][2] = a[2]; w[j][3] = a[3]; w[j][4] = b[0]; w[j][5] = b[1]; w[j][6] = b[2]; w[j][7] = b[3]; }
        v4u cg_[10], hv_[10], bg_[8];
#pragma unroll
        for (int k = 0; k < 10; ++k) { const int rr = r0 - 2 + k;
            if (k >= 2 || t0 > 0) { const bf16* row = PROJ + (size_t)rr * NAB; cg_[k] = *(const v4u*)(row + 4096 + c8); hv_[k] = *(const v4u*)(row + 5120 + c8); }
            else { cg_[k] = (v4u){0u, 0u, 0u, 0u}; hv_[k] = (v4u){0u, 0u, 0u, 0u}; } }
#pragma unroll
        for (int k = 0; k < 8; ++k) bg_[k] = *(const v4u*)(PROJ + (size_t)(r0 + k) * NAB + 3072 + c8);
        float z2[8], z1[8], z0[8];
        conv_unpack_mul(cg_[0], hv_[0], z2); conv_unpack_mul(cg_[1], hv_[1], z1);
#pragma unroll
        for (int k = 0; k < 8; ++k) {
            conv_unpack_mul(cg_[k + 2], hv_[k + 2], z0);
            float y[8];
#pragma unroll
            for (int e = 0; e < 8; ++e) y[e] = w[0][e] * z2[e] + w[1][e] * z1[e] + w[2][e] * z0[e];
            const v4u bg = bg_[k];
            v4u o; o.x = pk2(y[0] * bf_lo(bg.x), y[1] * bf_hi(bg.x)); o.y = pk2(y[2] * bf_lo(bg.y), y[3] * bf_hi(bg.y));
            o.z = pk2(y[4] * bf_lo(bg.z), y[5] * bf_hi(bg.z)); o.w = pk2(y[6] * bf_lo(bg.w), y[7] * bf_hi(bg.w));
            *(v4u*)(CAT + (size_t)(r0 + k) * DM + 1024 + c8) = o;
#pragma unroll
            for (int e = 0; e < 8; ++e) { z2[e] = z1[e]; z1[e] = z0[e]; }
        }
    }
}

constexpr int G_WP = 136, G_VP = 260;
constexpr int G_W_OFF = 0, G_V_OFF = 128 * G_WP * 2, G_ST_OFF = G_V_OFF + 128 * G_VP * 2;
__device__ __forceinline__ void gmlp_phase(const bf16* Z, bf16* US, const float* lnp, const float* w_s, const float* b_s, const float* ln_g, const float* ln_b,
                                           LAS unsigned char* lds, int cu, int G, int tid, int wave, int lane) {
    LAS bf16* wl = (LAS bf16*)(lds + G_W_OFF); LAS bf16* vl = (LAS bf16*)(lds + G_V_OFF); LAS float* st = (LAS float*)(lds + G_ST_OFF);
    const int fr = lane & 15, fq = lane >> 4;
    for (int unit = cu; unit < 512; unit += G) {
        const int nb = unit >> 3, g = unit & 7, row0 = nb * 128, ch0 = g * 256;
        { f32x4 wv[8];
#pragma unroll
          for (int p = 0; p < 8; ++p) { const int idx = tid + 512 * p, t = idx >> 5, s4 = (idx & 31) * 4; wv[p] = *(const f32x4*)(w_s + ((size_t)g * 128 + t) * 128 + s4); }
#pragma unroll
          for (int p = 0; p < 8; ++p) { const int idx = tid + 512 * p, t = idx >> 5, s4 = (idx & 31) * 4; f32x4 w = wv[p];
            if ((s4 >> 6) > (t >> 6)) w = (f32x4){0.f, 0.f, 0.f, 0.f};
            v2u o; o.x = pk2(w[0], w[1]); o.y = pk2(w[2], w[3]); *(LAS v2u*)(wl + t * G_WP + s4) = o; } }
        if (tid < 128) { const f32x4* p4 = (const f32x4*)(lnp + (size_t)(row0 + tid) * 64); float s = 0.f, q = 0.f;
#pragma unroll
            for (int j = 0; j < 16; ++j) { const f32x4 a = p4[j]; s += a[0] + a[2]; q += a[1] + a[3]; }
            const float mean = s * (1.0f / 2048.0f), var = q * (1.0f / 2048.0f) - mean * mean;
            st[tid * 2] = mean; st[tid * 2 + 1] = __builtin_amdgcn_rsqf(var + EPS); }
        LDS_WAIT(); __syncthreads();
        { const int c8 = (tid & 31) * 8;
          const f32x4 g0 = *(const f32x4*)(ln_g + ch0 + c8), g1 = *(const f32x4*)(ln_g + ch0 + c8 + 4), b0 = *(const f32x4*)(ln_b + ch0 + c8), b1 = *(const f32x4*)(ln_b + ch0 + c8 + 4);
          v4u vv[8]; float muv[8], rsv[8];
#pragma unroll
          for (int p = 0; p < 8; ++p) { const int s = (tid >> 5) + 16 * p; vv[p] = *(const v4u*)(Z + (size_t)(row0 + s) * NC + 2048 + ch0 + c8); muv[p] = st[s * 2]; rsv[p] = st[s * 2 + 1]; }
#pragma unroll
          for (int p = 0; p < 8; ++p) { const int s = (tid >> 5) + 16 * p; const v4u v = vv[p]; const float mu = muv[p], rstd = rsv[p];
              v2u o0, o1;
              o0.x = pk2((bf_lo(v.x) - mu) * rstd * g0[0] + b0[0], (bf_hi(v.x) - mu) * rstd * g0[1] + b0[1]); o0.y = pk2((bf_lo(v.y) - mu) * rstd * g0[2] + b0[2], (bf_hi(v.y) - mu) * rstd * g0[3] + b0[3]);
              o1.x = pk2((bf_lo(v.z) - mu) * rstd * g1[0] + b1[0], (bf_hi(v.z) - mu) * rstd * g1[1] + b1[1]); o1.y = pk2((bf_lo(v.w) - mu) * rstd * g1[2] + b1[2], (bf_hi(v.w) - mu) * rstd * g1[3] + b1[3]);
              *(LAS v2u*)(vl + s * G_VP + c8) = o0; *(LAS v2u*)(vl + s * G_VP + c8 + 4) = o1; } }
        LDS_WAIT(); __syncthreads();
        pg8::f32x4 acc[2][8];
#pragma unroll
        for (int a = 0; a < 2; ++a)
#pragma unroll
            for (int b = 0; b < 8; ++b) acc[a][b] = (pg8::f32x4){0.f, 0.f, 0.f, 0.f};
#pragma unroll
        for (int ks = 0; ks < 4; ++ks) {
            bf16x8 vf[2];
#pragma unroll
            for (int dt = 0; dt < 2; ++dt) { const LAS bf16* p = vl + (32 * ks + 8 * fq) * G_VP + wave * 32 + 8 * (fr >> 2) + 4 * dt + (fr & 3);
#pragma unroll
                for (int j = 0; j < 8; ++j) vf[dt][j] = (short)p[j * G_VP]; }
#pragma unroll
            for (int tt = 0; tt < 8; ++tt) { const bf16x8 wf = *(const LAS bf16x8*)(wl + (16 * tt + fr) * G_WP + 32 * ks + 8 * fq);
                acc[0][tt] = __builtin_amdgcn_mfma_f32_16x16x32_bf16(vf[0], wf, acc[0][tt], 0, 0, 0);
                acc[1][tt] = __builtin_amdgcn_mfma_f32_16x16x32_bf16(vf[1], wf, acc[1][tt], 0, 0, 0); }
        }
        { const size_t col = ch0 + wave * 32 + 8 * fq;
          v4u uu[8]; float bsv[8];
#pragma unroll
          for (int tt = 0; tt < 8; ++tt) { const int t = 16 * tt + fr; bsv[tt] = b_s[g * 128 + t]; uu[tt] = *(const v4u*)(Z + (size_t)(row0 + t) * NC + col); }
#pragma unroll
          for (int tt = 0; tt < 8; ++tt) { const int t = 16 * tt + fr; const float bs = bsv[tt]; const v4u u4 = uu[tt];
            const pg8::f32x4 a = acc[0][tt], c = acc[1][tt]; v4u o;
            o.x = pk2(bf_lo(u4.x) * (a[0] + bs), bf_hi(u4.x) * (a[1] + bs)); o.y = pk2(bf_lo(u4.y) * (a[2] + bs), bf_hi(u4.y) * (a[3] + bs));
            o.z = pk2(bf_lo(u4.z) * (c[0] + bs), bf_hi(u4.z) * (c[1] + bs)); o.w = pk2(bf_lo(u4.w) * (c[2] + bs), bf_hi(u4.w) * (c[3] + bs));
            *(v4u*)(US + (size_t)(row0 + t) * DM + col) = o; } }
        LDS_WAIT(); __syncthreads();
    }
}

#define XB_TMO      128
#define XB_XCNT(j)  (256  + 64 * (j))
#define XB_XSUB(j)  (1280 + 64 * (j))
#define XB_XGEN(j)  (2304 + 64 * (j))
#define XB_TOP      3328
#define XB_TOPGEN   3392
#define XCD_BAR_WORDS 3456
#define XB_SPIN_CAP (1u << 18)

__device__ __forceinline__ unsigned xb_ld(unsigned* p)              { return __hip_atomic_load(p, __ATOMIC_RELAXED, __HIP_MEMORY_SCOPE_AGENT); }
__device__ __forceinline__ unsigned xb_add(unsigned* p, unsigned v) { return __hip_atomic_fetch_add(p, v, __ATOMIC_RELAXED, __HIP_MEMORY_SCOPE_AGENT); }
__device__ __forceinline__ unsigned xb_xcc_id() { return (unsigned)__builtin_amdgcn_s_getreg((3 << 11) | 20) & 0xFu; }
#define XB_SPIN(cond, bar) do { unsigned _sp = 0; while (cond) { __builtin_amdgcn_s_sleep(1); \
    if ((++_sp & 255u) == 0u) { if (xb_ld(&(bar)[XB_TMO])) break; if (_sp > XB_SPIN_CAP) { atomicAdd(&(bar)[XB_TMO], 1u); break; } } } } while (0)

struct XcdBarrier {
    unsigned* bar; unsigned x;
    volatile LAS unsigned* st;
};

__device__ __forceinline__ XcdBarrier xcd_barrier_post(unsigned* bar, volatile LAS unsigned* st) {
    XcdBarrier b; b.bar = bar; b.x = xb_xcc_id(); b.st = st;
    if (threadIdx.x == 0) (void)xb_add(&bar[XB_XCNT(b.x)], 1u);
    return b;
}
__device__ __forceinline__ void xcd_barrier_complete(unsigned* bar, unsigned x, unsigned& nloc, unsigned& nx) {
    const unsigned G = gridDim.x * gridDim.y * gridDim.z;
    unsigned sum, cnt, mine, sp = 0u;
    for (;;) {
        sum = 0u; cnt = 0u; mine = 0u;
#pragma unroll
        for (unsigned j = 0; j < 16; ++j) { const unsigned c = xb_ld(&bar[XB_XCNT(j)]); sum += c; cnt += (c > 0u) ? 1u : 0u; mine = (j == x) ? c : mine; }
        if (sum == G) break;
        __builtin_amdgcn_s_sleep(1);
        if ((++sp & 255u) == 0u) { if (xb_ld(&bar[XB_TMO])) break; if (sp > XB_SPIN_CAP) { atomicAdd(&bar[XB_TMO], 1u); break; } }
    }
    nloc = mine > 0u ? mine : 1u; nx = cnt > 0u ? cnt : 1u;
}

__device__ __forceinline__ void xcd_barrier(const XcdBarrier& b) {
    asm volatile("s_waitcnt vmcnt(0)" ::: "memory");
    __syncthreads();
    if (threadIdx.x == 0) {
        unsigned* bar = b.bar;
        __builtin_amdgcn_s_waitcnt(0);
        unsigned nloc = b.st[0], nx = b.st[1];
        if (nloc == 0u) { xcd_barrier_complete(bar, b.x, nloc, nx); b.st[0] = nloc; b.st[1] = nx; }
        const unsigned old = xb_add(&bar[XB_XSUB(b.x)], 1u);
        const unsigned gen = old / nloc;
        if (old + 1u == (gen + 1u) * nloc) {
            __builtin_amdgcn_fence(__ATOMIC_RELEASE, "agent");
            asm volatile("s_waitcnt vmcnt(0)" ::: "memory");
            const unsigned og = xb_add(&bar[XB_TOP], 1u);
            const unsigned tg = og / nx;
            if (og + 1u == (tg + 1u) * nx) xb_add(&bar[XB_TOPGEN], 1u);
            else XB_SPIN(xb_ld(&bar[XB_TOPGEN]) == tg, bar);
            __builtin_amdgcn_fence(__ATOMIC_ACQUIRE, "agent");
            xb_add(&bar[XB_XGEN(b.x)], 1u);
            asm volatile("s_waitcnt vmcnt(0)" ::: "memory");
        } else {
            XB_SPIN(xb_ld(&bar[XB_XGEN(b.x)]) == gen, bar);
            __builtin_amdgcn_fence(__ATOMIC_ACQUIRE, "agent");
            asm volatile("s_waitcnt vmcnt(0)" ::: "memory");
        }
    }
    __syncthreads();
}

constexpr int CW_BAR = 1024;
__global__ void __launch_bounds__(NTHREADS, 2) mega_fwd(Args args_unused) {
    extern __shared__ __attribute__((aligned(16))) unsigned char lds_raw[];
    LAS unsigned char* lds = (LAS unsigned char*)lds_raw;
    cg::grid_group grid = cg::this_grid();
    if ((int)threadIdx.x < (int)(sizeof(Args) / 4)) ((LAS unsigned*)(lds + TBL_OFF))[threadIdx.x] = ((const unsigned*)__builtin_amdgcn_kernarg_segment_ptr())[threadIdx.x];
    if (threadIdx.x >= 40 && threadIdx.x < 48) ((LAS unsigned*)(lds + TBL_OFF))[threadIdx.x] = 0u;
    LDS_WAIT(); __syncthreads();
    if (threadIdx.x == 0) { unsigned* bar0 = (unsigned*)(WS_() + WS_CTL) + CW_BAR; (void)xb_add(&bar0[XB_XCNT(xb_xcc_id())], 1u); }
    LAS unsigned char* const lds_base = lds;
    const int lo = (int)tbl_u32(lds, 38), hi = (int)tbl_u32(lds, 39);
    for (int ph = lo; ph < hi; ++ph) {
        int tid = threadIdx.x; asm volatile("" : "+v"(tid));
        int cu = blockIdx.x; asm volatile("" : "+s"(cu));
        int G = gridDim.x; asm volatile("" : "+s"(G));
        unsigned ldso = 0; asm volatile("" : "+s"(ldso)); LAS unsigned char* lds = lds_base + ldso;
        const int lane = tid & 63, wave = __builtin_amdgcn_readfirstlane(tid >> 6);
        const int gw = cu * NWAVES + wave, NGW = G * NWAVES;
        if (ph == 0) { prologue_phase(lds, gw, NGW, wave, lane); }
        else if (ph == 21) { final_phase(OUT_G(), (const bf16*)(WS_G() + WS_XB), (const float*)(WS_G() + WS_STATS), IN_G(16), gw, NGW, lane); }
        else {
            const int l = (ph - 1) / 5, s = (ph - 1) % 5, i = l >> 1; const bool even = (l & 1) == 0;
#define WSP_G(T, off) ((T*)(WS_G() + (off)))
#define WSP_F(T, off) ((T*)(WS_() + (off)))
            if (s == 0 && even) {
                pg8::Gemm g{WSP_G(bf16, WS_XB), WSP_G(const bf16, WS_WAB_IN) + (size_t)i * NAB * DM, MROWS, NAB, DM}; pg8::StaticOrder S; S.init(MROWS, NAB, G, cu);
                const float* stats = WSP_G(const float, WS_STATS);
                int pm0; { pg8::Unit u0_; pm0 = S.next(0, u0_) ? u0_.pm : -1; }
                pg8::EpiScaleBf16 E{WSP_G(bf16, WS_PROJ), NAB, stats, (const LAS float*)(lds + RSTAB_OFF), pm0};
                pg8::gemm_phase<pg8::EpiScaleBf16, pg8::StaticOrder, PG8_ALIGN, PG8_SP2>(lds, g, S, E, tid);
            } else if (s == 0) {
                pg8::Gemm g{WSP_G(bf16, WS_XB), WSP_G(const bf16, WS_WC_IN) + (size_t)i * NC * DM, MROWS, NC, DM}; pg8::StaticOrder S; S.init(MROWS, NC, G, cu);
                const float* stats = WSP_G(const float, WS_STATS);
                int pm0; { pg8::Unit u0_; pm0 = S.next(0, u0_) ? u0_.pm : -1; }
                pg8::EpiGeluLN E{WSP_G(bf16, WS_PROJ), NC, stats, WSP_G(float, WS_LNP), (const LAS float*)(lds + RSTAB_OFF), pm0};
                pg8::gemm_phase<pg8::EpiGeluLN, pg8::StaticOrder, PG8_ALIGN, PG8_SP2>(lds, g, S, E, tid);
            } else if (s == 1 && even) {
                attn_phase(WSP_F(const bf16, WS_PROJ), WSP_F(bf16, WS_CAT), IN_(3) + (size_t)i * 8 * 513, lds, cu, G, tid, wave, lane);
                conv_phase(WSP_G(const bf16, WS_PROJ), WSP_G(bf16, WS_CAT), IN_G(4) + (size_t)i * 3 * 1024, cu * NTHREADS + tid, G * NTHREADS);
            } else if (s == 1) {
                gmlp_phase(WSP_G(const bf16, WS_PROJ), WSP_G(bf16, WS_CAT), WSP_G(const float, WS_LNP), IN_G(9) + (size_t)i * 8 * 128 * 128, IN_G(10) + (size_t)i * 8 * 128, IN_G(7) + (size_t)i * DM, IN_G(8) + (size_t)i * DM, lds, cu, G, tid, wave, lane);
            } else if (s == 3) {
                pg8::Gemm g{WSP_G(bf16, WS_XB), WSP_G(const bf16, WS_WGU) + (size_t)l * NGU * DM, MROWS, NGU, DM}; pg8::StaticOrder S; S.init(MROWS, NGU, G, cu);
                const float* stats = WSP_G(const float, WS_STATS);
                int pm0; { pg8::Unit u0_; pm0 = S.next(0, u0_) ? u0_.pm : -1; }
                pg8::EpiSwiGLU E{WSP_G(bf16, WS_HID), FFH, stats, (const LAS float*)(lds + RSTAB_OFF), pm0};
                pg8::gemm_phase<pg8::EpiSwiGLU, pg8::StaticOrder, PG8_ALIGN, PG8_SP2>(lds, g, S, E, tid);
                if (CVT_TAIL > 0 && l < 3 && cu >= 128 && G == 256) cvt_tail(lds, l + 1, cu, wave, lane);
            } else {
                unsigned char* wsg = WS_G();
                const bf16* Aop = s == 2 ? (const bf16*)(wsg + WS_CAT) : (const bf16*)(wsg + WS_HID); const int K = s == 2 ? DM : FFH;
                const bf16* Bop = s == 4 ? (const bf16*)(wsg + WS_WD) + (size_t)l * DM * FFH : (even ? (const bf16*)(wsg + WS_WAB_OUT) + (size_t)i * DM * DM : (const bf16*)(wsg + WS_WC_OUT) + (size_t)i * DM * DM);
                float* outp = (float*)(GAS float*)nullptr;
                pg8::Gemm g{Aop, Bop, MROWS, DM, K}; pg8::StaticOrder S; S.init(MROWS, DM, G, cu);
                pg8::EpiResidual E{(bf16*)(wsg + WS_XB), outp, (float*)(wsg + WS_STATS), DM};
                pg8::gemm_phase<pg8::EpiResidual, pg8::StaticOrder, false, PG8_SP2>(lds, g, S, E, tid);
            }
        }
        if (ph + 1 < hi) {
            if (hi > 64) grid.sync();
            else {    XcdBarrier xb_; xb_.bar = (unsigned*)(WS_() + WS_CTL) + CW_BAR; xb_.x = xb_xcc_id(); xb_.st = (volatile LAS unsigned*)(lds_base + TBL_OFF + 160); xcd_barrier(xb_); }
        }
    }
}

#ifndef MK_N_LAUNCHES
#define MK_N_LAUNCHES 1
#endif
extern "C" void kernel_launch(void* const* d_in, const int* in_sizes, int n_in, void* d_out, int out_size, void* d_ws, size_t ws_size, hipStream_t stream) {
    static int ready = 0;
    if (ready == 0) {
        if (n_in != 17 || in_sizes[0] != MROWS * DM || out_size != MROWS * DM || ws_size < WS_END) { fprintf(stderr, "kernel_launch: unexpected shapes (n_in %d, in0 %d, out %d, ws %zu)\n", n_in, n_in > 0 ? in_sizes[0] : -1, out_size, ws_size); ready = -1; return; }
        if (hipFuncSetAttribute((const void*)mega_fwd, hipFuncAttributeMaxDynamicSharedMemorySize, LDS_BYTES) != hipSuccess) { fprintf(stderr, "kernel_launch: hipFuncSetAttribute failed\n"); ready = -1; return; }
        int per_cu = 0;
        if (hipOccupancyMaxActiveBlocksPerMultiprocessor(&per_cu, (const void*)mega_fwd, NTHREADS, LDS_BYTES) != hipSuccess || per_cu < 1) fprintf(stderr, "kernel_launch: occupancy query says %d\n", per_cu);
        (void)hipGetLastError();
        ready = 1;
    }
    if (ready < 0) return;
    if (hipMemsetAsync((char*)d_ws + WS_CTL, 0, 65536, stream) != hipSuccess) { fprintf(stderr, "kernel_launch: memset failed\n"); return; }
    Args a{};
    for (int i = 0; i < 17; ++i) a.in[i] = (const float*)d_in[i];
    a.out = (float*)d_out; a.ws = (unsigned char*)d_ws;
    const int grid = 256;
#if MK_N_LAUNCHES == 1
    a.ph_lo = 0; a.ph_hi = 22;
    void* kargs[] = {&a};
    hipError_t e = hipLaunchCooperativeKernel((const void*)mega_fwd, dim3(grid), dim3(NTHREADS), kargs, LDS_BYTES, stream);
    if (e != hipSuccess) fprintf(stderr, "kernel_launch: cooperative launch failed: %s\n", hipGetErrorString(e));
#else
    for (int ph = 0; ph < 22; ++ph) { a.ph_lo = ph; a.ph_hi = ph + 1; hipLaunchKernelGGL(mega_fwd, dim3(grid), dim3(NTHREADS), LDS_BYTES, stream, a); }
#endif
}
```

```cpp
#include <hip/hip_runtime.h>
#include <hip/hip_cooperative_groups.h>
#include <cstdio>
#include <cstdint>
namespace cg = cooperative_groups;
namespace pg8 {
#define PG8_LAS __attribute__((address_space(3)))
typedef unsigned short bf16_t;
typedef short bf16x8 __attribute__((ext_vector_type(8)));
typedef float f32x4 __attribute__((ext_vector_type(4)));
typedef unsigned u32x4 __attribute__((ext_vector_type(4)));
constexpr int BM = 256, BK = 64, HALF = 128, HTB = HALF * BK * 2  , STAGE_BYTES = 8 * HTB, NXCD = 8, WGM = 8;

__host__ __device__ __forceinline__ int lds_byte(int r, int c) { const int st = (r >> 4) * 2 + (c >> 5), rr = r & 15, cc = c & 31, ob = rr * 64 + cc * 2; return st * 1024 + (ob ^ (((ob >> 9) & 1) << 5)); }
__host__ __device__ __forceinline__ void stage_rc(int b, int& R, int& C) { const int st = b / 1024, sb = b % 1024, swz = sb ^ (((sb >> 9) & 1) << 5); R = (st >> 1) * 16 + swz / 64; C = (st & 1) * 32 + (swz % 64) / 2; }
__host__ __device__ __forceinline__ int perm32(int rho) { const int n = rho >> 4, i = rho & 15; return 8 * (i >> 2) + 4 * n + (i & 3); }

struct Unit { int pm, pn; };
struct Gemm { const bf16_t* A; const bf16_t* Bt; int M, N, K; };

struct StaticOrder {
    int nM, nN, nwg, G, c;
    __host__ __device__ void init(int M, int N, int G_, int c_) { nM = M / BM; nN = N / BM; nwg = nM * nN; G = G_; c = c_; }
    __host__ __device__ bool next(int i, Unit& u) const {
        const long L = (long)i * G + c; if (L >= nwg) return false;
        int wgid = (int)L; { const int q = nwg / NXCD, r = nwg % NXCD, xcd = wgid % NXCD, off = wgid / NXCD; wgid = (xcd < r ? xcd * (q + 1) : r * (q + 1) + (xcd - r) * q) + off; }
        const int nig = WGM * nN, gid = wgid / nig, fm = gid * WGM, gsz = (nM - fm) < WGM ? (nM - fm) : WGM;
        u.pm = fm + ((wgid % nig) % gsz); u.pn = (wgid % nig) / gsz; return true;
    }
    __device__ __forceinline__ void a_ready(const Unit&) const {}
    __device__ __forceinline__ void done(const Unit&) const {}
};

typedef float cvt_f32x2 __attribute__((ext_vector_type(2))); typedef __bf16 cvt_bf16x2 __attribute__((ext_vector_type(2)));
__device__ __forceinline__ unsigned cvt_pk_bf16(float lo, float hi) { const cvt_f32x2 v = {lo, hi}; return __builtin_bit_cast(unsigned, __builtin_convertvector(v, cvt_bf16x2)); }
typedef float f32x2 __attribute__((ext_vector_type(2)));
__device__ __forceinline__ f32x2 gelu_pk(f32x2 v) {
    const f32x2 av = __builtin_elementwise_abs(v), d = av * 0.2316418882f + 1.0f;
    f32x2 t; t.x = __builtin_amdgcn_rcpf(d.x); t.y = __builtin_amdgcn_rcpf(d.y);
    f32x2 q = t * 0.5307027145f + (-0.7265760135f); q = q * t + 0.7107068705f; q = q * t + (-0.142248368f); q = q * t + 0.127414796f; q = q * t;
    const f32x2 s = (v * v) * (-0.72134752044f);
    f32x2 e; e.x = __builtin_amdgcn_exp2f(s.x); e.y = __builtin_amdgcn_exp2f(s.y);
    const f32x2 m = v * (q * e), r = v - m;
    f32x2 o; o.x = v.x < 0.f ? m.x : r.x; o.y = v.y < 0.f ? m.y : r.y; return o;
}
constexpr float RMS_EPS = 1e-6f;
__device__ __forceinline__ float row_rs(const float* stats, int row) {
    const f32x4 a = *(const f32x4*)(stats + (size_t)row * 8), b = *(const f32x4*)(stats + (size_t)row * 8 + 4);
    const float s = ((a[0] + a[1]) + (a[2] + a[3])) + ((b[0] + b[1]) + (b[2] + b[3]));
    return __builtin_amdgcn_rsqf(s * (1.0f / 2048.0f) + RMS_EPS);
}
#define RS_LOOKUP() ((u.pm == pm0) ? rstab[ai * HALF + wr * 64 + m * 16 + fr] : row_rs(stats, row))
struct EpiScaleBf16 {
    static constexpr bool PERM = true, AFTER_DRAIN = false;
    bf16_t* O; int ldc; const float* stats; const PG8_LAS float* rstab; int pm0; int zpn;
    __device__ __forceinline__ void prefill(int tid) const { if (pm0 >= 0 && tid < 256) ((PG8_LAS float*)rstab)[tid] = row_rs(stats, pm0 * BM + tid); }
    __device__ __forceinline__ void operator()(const f32x4 (&acc)[2][2][4][2], const Unit& u, int wr, int wc, int fr, int fq) const {
        const int row0 = u.pm * BM + wr * 64 + fr, col0 = u.pn * BM + wc * 32 + 8 * fq;
        if (zpn >= 0 && u.pn >= zpn) {
            const int colz = zpn * BM + (u.pn - zpn) * HALF + wc * 32 + 8 * fq;
#pragma unroll
            for (int ai = 0; ai < 2; ++ai)
#pragma unroll
                for (int m = 0; m < 4; ++m) { const int row = row0 + ai * HALF + m * 16; const float rs = RS_LOOKUP(); const float rs2 = rs * rs;
                    const f32x4 p0 = acc[ai][0][m][0] * acc[ai][1][m][0] * rs2, p1 = acc[ai][0][m][1] * acc[ai][1][m][1] * rs2;
                    u32x4 w; w.x = cvt_pk_bf16(p0[0], p0[1]); w.y = cvt_pk_bf16(p0[2], p0[3]); w.z = cvt_pk_bf16(p1[0], p1[1]); w.w = cvt_pk_bf16(p1[2], p1[3]);
                    *(u32x4*)(O + (size_t)row * ldc + colz) = w; }
            return; }
#pragma unroll
        for (int ai = 0; ai < 2; ++ai)
#pragma unroll
            for (int m = 0; m < 4; ++m) { const int row = row0 + ai * HALF + m * 16; const float rs = RS_LOOKUP(); bf16_t* rowp = O + (size_t)row * ldc + col0;
#pragma unroll
                for (int bj = 0; bj < 2; ++bj) { const f32x4 v0 = acc[ai][bj][m][0] * rs, v1 = acc[ai][bj][m][1] * rs;
                    u32x4 w; w.x = cvt_pk_bf16(v0[0], v0[1]); w.y = cvt_pk_bf16(v0[2], v0[3]); w.z = cvt_pk_bf16(v1[0], v1[1]); w.w = cvt_pk_bf16(v1[2], v1[3]);
                    *(u32x4*)(rowp + bj * HALF) = w; } }
    }
};
__device__ __forceinline__ float silu_mul(float g, float u) { return g * u * __builtin_amdgcn_rcpf(1.0f + __builtin_amdgcn_exp2f(g * -1.4426950408889634f)); }
struct EpiSwiGLU {
    static constexpr bool PERM = true, AFTER_DRAIN = false;
    bf16_t* O; int ldc; const float* stats; const PG8_LAS float* rstab; int pm0;
    __device__ __forceinline__ void prefill(int tid) const { if (pm0 >= 0 && tid < 256) ((PG8_LAS float*)rstab)[tid] = row_rs(stats, pm0 * BM + tid); }
    __device__ __forceinline__ void operator()(const f32x4 (&acc)[2][2][4][2], const Unit& u, int wr, int wc, int fr, int fq) const {
        const int row0 = u.pm * BM + wr * 64 + fr, col0 = u.pn * HALF + wc * 32 + 8 * fq;
#pragma unroll
        for (int ai = 0; ai < 2; ++ai)
#pragma unroll
            for (int m = 0; m < 4; ++m) { const int row = row0 + ai * HALF + m * 16; const float rs = RS_LOOKUP();
                const f32x4 g0 = acc[ai][0][m][0] * rs, g1 = acc[ai][0][m][1] * rs, u0 = acc[ai][1][m][0] * rs, u1 = acc[ai][1][m][1] * rs;
                u32x4 w; w.x = cvt_pk_bf16(silu_mul(g0[0], u0[0]), silu_mul(g0[1], u0[1])); w.y = cvt_pk_bf16(silu_mul(g0[2], u0[2]), silu_mul(g0[3], u0[3]));
                w.z = cvt_pk_bf16(silu_mul(g1[0], u1[0]), silu_mul(g1[1], u1[1])); w.w = cvt_pk_bf16(silu_mul(g1[2], u1[2]), silu_mul(g1[3], u1[3]));
                *(u32x4*)(O + (size_t)row * ldc + col0) = w; }
    }
};
struct EpiGeluLN {
    static constexpr bool PERM = true, AFTER_DRAIN = false;
    bf16_t* O; int ldc; const float* stats; float* lnp; const PG8_LAS float* rstab; int pm0;
    __device__ __forceinline__ void prefill(int tid) const { if (pm0 >= 0 && tid < 256) ((PG8_LAS float*)rstab)[tid] = row_rs(stats, pm0 * BM + tid); }
    __device__ __forceinline__ void operator()(const f32x4 (&acc)[2][2][4][2], const Unit& u, int wr, int wc, int fr, int fq) const {
        const int row0 = u.pm * BM + wr * 64 + fr, col0 = u.pn * BM + wc * 32 + 8 * fq;
#pragma unroll
        for (int ai = 0; ai < 2; ++ai)
#pragma unroll
            for (int m = 0; m < 4; ++m) { const int row = row0 + ai * HALF + m * 16; const float rs = RS_LOOKUP(); bf16_t* rowp = O + (size_t)row * ldc + col0; float s = 0.f, q = 0.f;
#pragma unroll
                for (int bj = 0; bj < 2; ++bj) { f32x4 v0 = acc[ai][bj][m][0] * rs, v1 = acc[ai][bj][m][1] * rs;
                    { f32x2 a = gelu_pk((f32x2){v0[0], v0[1]}), b = gelu_pk((f32x2){v0[2], v0[3]}), c = gelu_pk((f32x2){v1[0], v1[1]}), d = gelu_pk((f32x2){v1[2], v1[3]});
                      v0 = (f32x4){a.x, a.y, b.x, b.y}; v1 = (f32x4){c.x, c.y, d.x, d.y}; }
                    s += ((v0[0] + v0[1]) + (v0[2] + v0[3])) + ((v1[0] + v1[1]) + (v1[2] + v1[3]));
                    q += ((v0[0] * v0[0] + v0[1] * v0[1]) + (v0[2] * v0[2] + v0[3] * v0[3])) + ((v1[0] * v1[0] + v1[1] * v1[1]) + (v1[2] * v1[2] + v1[3] * v1[3]));
                    u32x4 w; w.x = cvt_pk_bf16(v0[0], v0[1]); w.y = cvt_pk_bf16(v0[2], v0[3]); w.z = cvt_pk_bf16(v1[0], v1[1]); w.w = cvt_pk_bf16(v1[2], v1[3]);
                    *(u32x4*)(rowp + bj * HALF) = w; }
                if (u.pn >= 8) { s += __shfl_xor(s, 16); s += __shfl_xor(s, 32); q += __shfl_xor(q, 16); q += __shfl_xor(q, 32);
                    if (fq == 0) *(f32x2*)(lnp + ((size_t)row * 32 + (u.pn - 8) * 4 + wc) * 2) = (f32x2){s, q}; } }
    }
};
struct EpiResidual {
    static constexpr bool PERM = true, AFTER_DRAIN = true;
    bf16_t* xb; float* xout; float* stats; int ldc;
    __device__ __forceinline__ void prefill(int) const {}
    __device__ __forceinline__ void init(f32x4 (&acc)[2][2][4][2], const Unit& u, int wr, int wc, int fr, int fq) const {
        const int col0 = u.pn * BM + wc * 32 + 8 * fq;
#pragma unroll
        for (int ai = 0; ai < 2; ++ai)
#pragma unroll
            for (int m = 0; m < 4; ++m) { const int r = ai * HALF + wr * 64 + m * 16 + fr; const size_t off = (size_t)(u.pm * BM + r) * ldc + col0;
#pragma unroll
                for (int bj = 0; bj < 2; ++bj) { const u32x4 xw = *(const u32x4*)(xb + off + bj * HALF);
                    acc[ai][bj][m][0] = (f32x4){__uint_as_float(xw.x << 16), __uint_as_float(xw.x & 0xffff0000u), __uint_as_float(xw.y << 16), __uint_as_float(xw.y & 0xffff0000u)};
                    acc[ai][bj][m][1] = (f32x4){__uint_as_float(xw.z << 16), __uint_as_float(xw.z & 0xffff0000u), __uint_as_float(xw.w << 16), __uint_as_float(xw.w & 0xffff0000u)}; } }
    }
    __device__ __forceinline__ void fused(f32x4 (&acc)[2][2][4][2], const Unit& u, int wr, int wc, int fr, int fq, PG8_LAS unsigned char* lds, int wid, int lane) const {
        PG8_LAS float* P = (PG8_LAS float*)lds;
        const int col0 = u.pn * BM + wc * 32 + 8 * fq;
#pragma unroll
        for (int ai = 0; ai < 2; ++ai)
#pragma unroll
            for (int m = 0; m < 4; ++m) { const int r = ai * HALF + wr * 64 + m * 16 + fr; const size_t off = (size_t)(u.pm * BM + r) * ldc + col0; float q = 0.f;
#pragma unroll
                for (int bj = 0; bj < 2; ++bj) { const f32x4 o0 = acc[ai][bj][m][0], o1 = acc[ai][bj][m][1];
                    u32x4 w; w.x = cvt_pk_bf16(o0[0], o0[1]); w.y = cvt_pk_bf16(o0[2], o0[3]); w.z = cvt_pk_bf16(o1[0], o1[1]); w.w = cvt_pk_bf16(o1[2], o1[3]);
                    *(u32x4*)(xb + off + bj * HALF) = w;
                    const float r0 = __uint_as_float(w.x << 16), r1 = __uint_as_float(w.x & 0xffff0000u), r2 = __uint_as_float(w.y << 16), r3 = __uint_as_float(w.y & 0xffff0000u);
                    const float r4 = __uint_as_float(w.z << 16), r5 = __uint_as_float(w.z & 0xffff0000u), r6 = __uint_as_float(w.w << 16), r7 = __uint_as_float(w.w & 0xffff0000u);
                    q += ((r0 * r0 + r1 * r1) + (r2 * r2 + r3 * r3)) + ((r4 * r4 + r5 * r5) + (r6 * r6 + r7 * r7)); }
                q += __shfl_xor(q, 16); q += __shfl_xor(q, 32);
                if (fq == 0) P[r * 4 + wc] = q;
                }
        asm volatile("s_waitcnt lgkmcnt(0)" ::: "memory"); __builtin_amdgcn_s_barrier(); asm volatile("" ::: "memory");
        const int tid = wid * 64 + lane;
        if (tid < 256) { const f32x4 p = *(const PG8_LAS f32x4*)(P + tid * 4); stats[(size_t)(u.pm * BM + tid) * 8 + u.pn] = (p[0] + p[1]) + (p[2] + p[3]); }
    }
};

template <class Epi, class Sched, bool ALIGN_EPI = false, bool SP2 = false>
__device__ __forceinline__ void gemm_phase(PG8_LAS unsigned char* lds, const Gemm g, const Sched& S, const Epi& E, const int tid) {
    const int wid = __builtin_amdgcn_readfirstlane(tid >> 6), lane = tid & 63, wr = wid >> 2, wc = wid & 3, fr = lane & 15, fq = lane >> 4;
    const int K = g.K, nt = K / BK;
    unsigned voffA[2], voffB[2];
#pragma unroll
    for (int i = 0; i < 2; ++i) { int R, C; stage_rc(tid * 16 + i * 8192, R, C); const int Rb = Epi::PERM ? ((R & ~31) + perm32(R & 31)) : R;
        voffA[i] = (unsigned)(R * K + C) * 2u; voffB[i] = (unsigned)(Rb * K + C) * 2u; }
    const size_t kstep = (size_t)(BK * 2);
    const size_t hstep = (size_t)HALF * K * 2;
    const size_t tstep = 2 * hstep;
    const unsigned ldsw = (unsigned)wid * 1024u;
    const int aoff = lds_byte(wr * 64 + fr, fq * 8), boff = lds_byte(wc * 32 + fr, fq * 8);
#define PG8_SA(b, h) (((b) * 2 + (h)) * HTB)
#define PG8_SB(b, h) ((4 + (b) * 2 + (h)) * HTB)
#define PG8_STAGE(bufoff, gbase, voff) do { _Pragma("unroll") for (int _i = 0; _i < 2; ++_i) \
        __builtin_amdgcn_global_load_lds((const unsigned*)((const char*)(gbase) + (voff)[_i]), (PG8_LAS unsigned*)(lds + (bufoff) + ldsw + _i * 8192), 16, 0, 0); } while (0)
#define PG8_LDA(dst, b, h) do { _Pragma("unroll") for (int m = 0; m < 4; ++m) _Pragma("unroll") for (int k = 0; k < 2; ++k) dst[m][k] = *(const PG8_LAS bf16x8*)(lds + PG8_SA(b, h) + aoff + m * 2048 + k * 1024); } while (0)
#define PG8_LDB(dst, b, h) do { _Pragma("unroll") for (int n = 0; n < 2; ++n) _Pragma("unroll") for (int k = 0; k < 2; ++k) dst[n][k] = *(const PG8_LAS bf16x8*)(lds + PG8_SB(b, h) + boff + n * 2048 + k * 1024); } while (0)
#define PG8_MMA(ai, bj, At, Bt) do { __builtin_amdgcn_s_setprio(1); _Pragma("unroll") for (int m = 0; m < 4; ++m) _Pragma("unroll") for (int n = 0; n < 2; ++n) _Pragma("unroll") for (int k = 0; k < 2; ++k) \
        acc[ai][bj][m][n] = __builtin_amdgcn_mfma_f32_16x16x32_bf16(Bt[n][k], At[m][k], acc[ai][bj][m][n], 0, 0, 0); __builtin_amdgcn_s_setprio(0); } while (0)
#define PG8_WAIT_V(n) asm volatile("s_waitcnt vmcnt(" #n ")" ::: "memory")
#define PG8_WAIT_L(n) asm volatile("s_waitcnt lgkmcnt(" #n ")" ::: "memory")
#define PG8_BAR __builtin_amdgcn_s_barrier()
#define PG8_SCHED __builtin_amdgcn_sched_barrier(0)
    Unit cur, nxt; int ui = 0;
    if (!S.next(0, cur)) return;
    f32x4 acc[2][2][4][2];
    if constexpr (Epi::AFTER_DRAIN) E.init(acc, cur, wr, wc, fr, fq);
    else {
#pragma unroll
    for (int a = 0; a < 2; ++a)
#pragma unroll
        for (int b = 0; b < 2; ++b)
#pragma unroll
            for (int m = 0; m < 4; ++m)
#pragma unroll
                for (int n = 0; n < 2; ++n) acc[a][b][m][n] = (f32x4){0.f, 0.f, 0.f, 0.f};
    }
    bf16x8 At[4][2], B0[2][2], B1[2][2];
    const char* cA = (const char*)g.A + (size_t)cur.pm * tstep; const char* cB = (const char*)g.Bt + (size_t)cur.pn * tstep;
    S.a_ready(cur);
    if constexpr (SP2) {
        PG8_STAGE(PG8_SB(0, 0), cB, voffB); PG8_STAGE(PG8_SB(0, 1), cB + hstep, voffB); PG8_STAGE(PG8_SA(0, 0), cA, voffA); PG8_STAGE(PG8_SA(0, 1), cA + hstep, voffA);
        E.prefill(tid);
        if (wr == 1) PG8_BAR;
        PG8_WAIT_V(2); PG8_BAR;
        PG8_STAGE(PG8_SB(1, 0), cB + kstep, voffB); PG8_STAGE(PG8_SA(1, 0), cA + kstep, voffA); PG8_STAGE(PG8_SB(1, 1), cB + hstep + kstep, voffB);
        PG8_WAIT_V(6); PG8_BAR;
    } else {
        PG8_STAGE(PG8_SB(0, 0), cB, voffB); PG8_STAGE(PG8_SA(0, 0), cA, voffA); PG8_STAGE(PG8_SB(0, 1), cB + hstep, voffB); PG8_STAGE(PG8_SA(0, 1), cA + hstep, voffA);
        E.prefill(tid);
        if (wr == 1) PG8_BAR;
        PG8_WAIT_V(4); PG8_BAR;
        PG8_STAGE(PG8_SB(1, 0), cB + kstep, voffB); PG8_STAGE(PG8_SA(1, 0), cA + kstep, voffA); PG8_STAGE(PG8_SB(1, 1), cB + hstep + kstep, voffB);
        PG8_WAIT_V(6); PG8_BAR;
    }
    for (;;) {
        const bool has_next = S.next(ui + 1, nxt);
        const char* nA = has_next ? (const char*)g.A + (size_t)nxt.pm * tstep : cA; const char* nB = has_next ? (const char*)g.Bt + (size_t)nxt.pn * tstep : cB;
        for (int t = 0; t < nt; t += 2) {
            const bool last = (t == nt - 2);
            const char* a1 = cA + (size_t)(t + 1) * kstep;
            const char* a2 = last ? nA : cA + (size_t)(t + 2) * kstep; const char* b2 = last ? nB : cB + (size_t)(t + 2) * kstep;
            const char* a3 = a2 + kstep; const char* b3 = b2 + kstep;
            if (last && has_next) S.a_ready(nxt);
            if constexpr (SP2) {
            PG8_LDB(B0, 0, 0); PG8_LDB(B1, 0, 1); PG8_SCHED; PG8_LDA(At, 0, 0); PG8_STAGE(PG8_SA(1, 1), a1 + hstep, voffA);
            PG8_WAIT_V(8); PG8_WAIT_L(0); PG8_BAR; PG8_MMA(0, 0, At, B0); PG8_MMA(0, 1, At, B1); PG8_BAR; PG8_SCHED;
            PG8_LDA(At, 0, 1); PG8_STAGE(PG8_SB(0, 0), b2, voffB); PG8_STAGE(PG8_SB(0, 1), b2 + hstep, voffB); PG8_STAGE(PG8_SA(0, 0), a2, voffA);
            PG8_WAIT_V(8); PG8_WAIT_L(0); PG8_BAR; PG8_MMA(1, 0, At, B0); PG8_MMA(1, 1, At, B1); PG8_BAR; PG8_SCHED;
            PG8_LDB(B0, 1, 0); PG8_LDB(B1, 1, 1); PG8_SCHED; PG8_LDA(At, 1, 0); PG8_STAGE(PG8_SA(0, 1), a2 + hstep, voffA);
            PG8_WAIT_V(8); PG8_WAIT_L(0); PG8_BAR; PG8_MMA(0, 0, At, B0); PG8_MMA(0, 1, At, B1); PG8_BAR; PG8_SCHED;
            PG8_LDA(At, 1, 1); PG8_STAGE(PG8_SB(1, 0), b3, voffB); PG8_STAGE(PG8_SB(1, 1), b3 + hstep, voffB); PG8_STAGE(PG8_SA(1, 0), a3, voffA);
            PG8_WAIT_V(8); PG8_WAIT_L(0); PG8_BAR; PG8_MMA(1, 0, At, B0); PG8_MMA(1, 1, At, B1); PG8_BAR; PG8_SCHED;
            } else {
            PG8_LDB(B0, 0, 0); PG8_SCHED; PG8_LDA(At, 0, 0); PG8_STAGE(PG8_SA(1, 1), a1 + hstep, voffA);
            PG8_WAIT_L(8); PG8_BAR; PG8_WAIT_L(0); PG8_MMA(0, 0, At, B0); PG8_BAR; PG8_SCHED;
            PG8_LDB(B1, 0, 1); PG8_STAGE(PG8_SB(0, 0), b2, voffB);
            PG8_BAR; PG8_WAIT_L(0); PG8_MMA(0, 1, At, B1); PG8_BAR;
            PG8_LDA(At, 0, 1); PG8_STAGE(PG8_SA(0, 0), a2, voffA);
            PG8_BAR; PG8_WAIT_L(0); PG8_MMA(1, 0, At, B0); PG8_BAR; PG8_SCHED;
            PG8_STAGE(PG8_SB(0, 1), b2 + hstep, voffB);
            PG8_WAIT_V(6); PG8_BAR; PG8_MMA(1, 1, At, B1); PG8_BAR;
            PG8_LDB(B0, 1, 0); PG8_SCHED; PG8_LDA(At, 1, 0); PG8_STAGE(PG8_SA(0, 1), a2 + hstep, voffA);
            PG8_WAIT_L(8); PG8_BAR; PG8_WAIT_L(0); PG8_MMA(0, 0, At, B0); PG8_BAR; PG8_SCHED;
            PG8_LDB(B1, 1, 1); PG8_STAGE(PG8_SB(1, 0), b3, voffB);
            PG8_BAR; PG8_WAIT_L(0); PG8_MMA(0, 1, At, B1); PG8_BAR;
            PG8_LDA(At, 1, 1); PG8_STAGE(PG8_SA(1, 0), a3, voffA);
            PG8_BAR; PG8_WAIT_L(0); PG8_MMA(1, 0, At, B0); PG8_BAR; PG8_SCHED;
            PG8_STAGE(PG8_SB(1, 1), b3 + hstep, voffB);
            PG8_WAIT_V(6); PG8_BAR; PG8_MMA(1, 1, At, B1); PG8_BAR;
            }
        }
        if constexpr (ALIGN_EPI) { if (wr == 0) PG8_BAR; }
        if constexpr (!Epi::AFTER_DRAIN) { E(acc, cur, wr, wc, fr, fq); S.done(cur); }
        if (!has_next) break;
#pragma unroll
        for (int a = 0; a < 2; ++a)
#pragma unroll
            for (int b = 0; b < 2; ++b)
#pragma unroll
                for (int m = 0; m < 4; ++m)
#pragma unroll
                    for (int n = 0; n < 2; ++n) acc[a][b][m][n] = (f32x4){0.f, 0.f, 0.f, 0.f};
        cur = nxt; cA = nA; cB = nB; ++ui;
        if constexpr (ALIGN_EPI) { if (wr == 1) PG8_BAR; }
    }
    PG8_WAIT_V(0);
    if constexpr (!ALIGN_EPI) { if (wr == 0) PG8_BAR; }
    PG8_BAR;
    if constexpr (Epi::AFTER_DRAIN) { E.fused(acc, cur, wr, wc, fr, fq, lds, wid, lane); S.done(cur); }
#undef PG8_SA
#undef PG8_SB
#undef PG8_STAGE
#undef PG8_LDA
#undef PG8_LDB
#undef PG8_MMA
#undef PG8_WAIT_V
#undef PG8_WAIT_L
#undef PG8_BAR
#undef PG8_SCHED
}
}
#ifndef PG8_SP2
#define PG8_SP2 true
#endif
#ifndef PG8_ALIGN
#define PG8_ALIGN true
#endif
#define GAS __attribute__((address_space(1)))
#define LAS __attribute__((address_space(3)))
typedef unsigned short bf16;
typedef unsigned v4u __attribute__((ext_vector_type(4)));
typedef unsigned v2u __attribute__((ext_vector_type(2)));
typedef float f32x4 __attribute__((ext_vector_type(4)));
typedef float f32x2 __attribute__((ext_vector_type(2)));
typedef short bf16x8 __attribute__((ext_vector_type(8)));
#define LDS_WAIT() asm volatile("s_waitcnt lgkmcnt(0)" ::: "memory")

constexpr int DM = 2048, MROWS = 8192, SEQ = 2048, FFH = 5632, NAB = 6144, NC = 4096, NGU = 2 * FFH;
constexpr float EPS = 1e-6f;
constexpr int NWAVES = 8, NTHREADS = 512, LDS_BYTES = 155648;
constexpr size_t MiB = 1u << 20;
constexpr size_t WS_CTL = 0, CTL_ZERO_BYTES = 1 * MiB;
constexpr size_t WS_STATS = 1 * MiB;
constexpr size_t WS_LNP = 2 * MiB;
constexpr size_t WS_WAB_IN = 4 * MiB;
constexpr size_t WS_WAB_OUT = WS_WAB_IN + 48 * MiB;
constexpr size_t WS_WC_IN = WS_WAB_OUT + 16 * MiB;
constexpr size_t WS_WC_OUT = WS_WC_IN + 32 * MiB;
constexpr size_t WS_WGU = WS_WC_OUT + 16 * MiB;
constexpr size_t WS_WD = WS_WGU + 176 * MiB;
constexpr size_t WS_XB = WS_WD + 88 * MiB;
constexpr size_t WS_CAT = WS_XB + 32 * MiB;
constexpr size_t WS_PROJ = WS_CAT + 32 * MiB;
constexpr size_t WS_HID = WS_PROJ + 96 * MiB;
constexpr size_t WS_END = WS_HID + 88 * MiB;

__device__ __forceinline__ float bf_lo(unsigned w) { return __uint_as_float(w << 16); }
__device__ __forceinline__ float bf_hi(unsigned w) { return __uint_as_float(w & 0xffff0000u); }
__device__ __forceinline__ unsigned pk2(float lo, float hi) { return pg8::cvt_pk_bf16(lo, hi); }
__device__ __forceinline__ float wave_sum(float v) {
#pragma unroll
    for (int o = 1; o < 64; o <<= 1) v += __shfl_xor(v, o);
    return v;
}
__device__ __forceinline__ float wave_max(float v) {
#pragma unroll
    for (int o = 1; o < 64; o <<= 1) v = fmaxf(v, __shfl_xor(v, o));
    return v;
}

#ifndef CVT_2D
#define CVT_2D 0
#endif
struct CvtD { const float* W; const float* g; bf16* WT; int K, N, k0, n0, drow0; };
struct CvtV { f32x4 v[16]; float gv; };
__device__ __forceinline__ void cvt_desc(CvtD& d, const float* W, int K, int N, bf16* WT, const float* g, int mode, int item) {
#if CVT_2D
    const int nblk2 = N >> 7, grp = item >> 3, w8 = item & 7, kbg = grp / nblk2, nbg = grp - kbg * nblk2, kb = 4 * kbg + (w8 >> 1), nb = 2 * nbg + (w8 & 1);
#else
    const int nblk = N >> 6, kb = item / nblk, nb = item - kb * nblk;
#endif
    d.W = W; d.g = g; d.WT = WT; d.K = K; d.N = N; d.k0 = kb << 6; d.n0 = nb << 6;
    d.drow0 = mode == 0 ? d.n0
            : mode == 3 ? (d.n0 < 4096 ? d.n0 : d.n0 < 5120 ? 4096 + ((d.n0 - 4096) >> 7) * 256 + ((d.n0 - 4096) & 127) : 4096 + ((d.n0 - 5120) >> 7) * 256 + 128 + ((d.n0 - 5120) & 127))
            : ((d.n0 >> 7) * 256 + (d.n0 & 127) + (mode == 2 ? 128 : 0));
}
__device__ __forceinline__ void cvt_load(const CvtD& d, CvtV& r, int lane) {
    const int c4 = (lane & 15) * 4, kq = lane >> 4;
    r.gv = d.g ? d.g[d.k0 + lane] : 1.0f;
#pragma unroll
    for (int i = 0; i < 16; ++i) r.v[i] = *(const f32x4*)(d.W + (size_t)(d.k0 + 4 * i + kq) * d.N + d.n0 + c4);
}
__device__ __forceinline__ void cvt_finish(const CvtD& d, const CvtV& r, LAS float* scr, int lane) {
    const int c4 = (lane & 15) * 4, kq = lane >> 4;
#pragma unroll
    for (int i = 0; i < 16; ++i) { const int kk = 4 * i + kq; const float gg = __shfl(r.gv, kk); LAS float* s = scr + kk * 65 + c4;
        s[0] = r.v[i][0] * gg; s[1] = r.v[i][1] * gg; s[2] = r.v[i][2] * gg; s[3] = r.v[i][3] * gg; }
    LDS_WAIT(); asm volatile("" ::: "memory");
    const int c = lane & 7;
#pragma unroll
    for (int p = 0; p < 8; ++p) { const int n = (lane >> 3) + 8 * p; const LAS float* s = scr + (8 * c) * 65 + n;
        v4u o; o.x = pk2(s[0 * 65], s[1 * 65]); o.y = pk2(s[2 * 65], s[3 * 65]); o.z = pk2(s[4 * 65], s[5 * 65]); o.w = pk2(s[6 * 65], s[7 * 65]);
        *(v4u*)(d.WT + (size_t)(d.drow0 + n) * d.K + d.k0 + 8 * c) = o; }
    LDS_WAIT(); asm volatile("" ::: "memory");
}

struct Args { const float* in[17]; float* out; unsigned char* ws; int ph_lo, ph_hi; };
constexpr int TBL_OFF = LDS_BYTES - 256, RSTAB_OFF = 131072;
__device__ __forceinline__ unsigned tbl_u32(LAS unsigned char* lds, int w) { return (unsigned)__builtin_amdgcn_readfirstlane((int)((volatile LAS unsigned*)(lds + TBL_OFF))[w]); }
__device__ __forceinline__ const float* tbl_ptr(LAS unsigned char* lds, int k) { const unsigned lo = tbl_u32(lds, 2 * k), hi = tbl_u32(lds, 2 * k + 1); return (const float*)(((unsigned long long)hi << 32) | lo); }
__device__ __forceinline__ const float* tbl_ptr_g(LAS unsigned char* lds, int k) { const unsigned lo = tbl_u32(lds, 2 * k), hi = tbl_u32(lds, 2 * k + 1); return (const float*)(GAS const float*)(((unsigned long long)hi << 32) | lo); }
#define IN_(k) tbl_ptr(lds, (k))
#define OUT_() ((float*)tbl_ptr(lds, 17))
#define WS_() ((unsigned char*)tbl_ptr(lds, 18))
#define WS_G() ((unsigned char*)tbl_ptr_g(lds, 18))
#define OUT_G() ((float*)tbl_ptr_g(lds, 17))
#define IN_G(k) tbl_ptr_g(lds, (k))

#ifndef CVT_TAIL
#define CVT_TAIL 6144
#endif
constexpr int I_ABIN = 32 * 96, I_SQ = 32 * 32, I_CIN = 32 * 64, I_FF = 32 * 88;
__host__ __device__ constexpr int cvt_layer_items(int L) { return ((L & 1) ? I_CIN : I_ABIN) + I_SQ + 3 * I_FF; }
__device__ __forceinline__ void cvt_layer_desc(CvtD& d, LAS unsigned char* lds, int L, int j) {
    unsigned char* ws = WS_G();
    const int i = L >> 1; const bool even = (L & 1) == 0; const int n_in = even ? I_ABIN : I_CIN;
    if (j < n_in) {
        if (even) cvt_desc(d, IN_G(2) + (size_t)i * DM * NAB, DM, NAB, (bf16*)(ws + WS_WAB_IN) + (size_t)i * NAB * DM, IN_G(1) + (size_t)L * DM, 3, j);
        else cvt_desc(d, IN_G(6) + (size_t)i * DM * NC, DM, NC, (bf16*)(ws + WS_WC_IN) + (size_t)i * NC * DM, IN_G(1) + (size_t)L * DM, 0, j);
        return; }
    j -= n_in;
    if (j < I_SQ) {
        if (even) cvt_desc(d, IN_G(5) + (size_t)i * DM * DM, DM, DM, (bf16*)(ws + WS_WAB_OUT) + (size_t)i * DM * DM, nullptr, 0, j);
        else cvt_desc(d, IN_G(11) + (size_t)i * DM * DM, DM, DM, (bf16*)(ws + WS_WC_OUT) + (size_t)i * DM * DM, nullptr, 0, j);
        return; }
    j -= I_SQ;
    if (j < I_FF) { cvt_desc(d, IN_G(13) + (size_t)L * DM * FFH, DM, FFH, (bf16*)(ws + WS_WGU) + (size_t)L * NGU * DM, IN_G(12) + (size_t)L * DM, 1, j); return; }
    j -= I_FF;
    if (j < I_FF) { cvt_desc(d, IN_G(14) + (size_t)L * DM * FFH, DM, FFH, (bf16*)(ws + WS_WGU) + (size_t)L * NGU * DM, IN_G(12) + (size_t)L * DM, 2, j); return; }
    j -= I_FF;
    cvt_desc(d, IN_G(15) + (size_t)L * FFH * DM, FFH, DM, (bf16*)(ws + WS_WD) + (size_t)L * DM * FFH, nullptr, 0, j);
}
__device__ __forceinline__ void pro_desc(CvtD& d, LAS unsigned char* lds, int it) {
    constexpr int P0 = cvt_layer_items(0), P1 = cvt_layer_items(1) - CVT_TAIL, P2 = cvt_layer_items(2) - CVT_TAIL;
    int r = it, L = 0;
    if (r >= P0) { r -= P0; L = 1; if (r >= P1) { r -= P1; L = 2; if (r >= P2) { r -= P2; L = 3; } } }
    cvt_layer_desc(d, lds, L, r);
}
__device__ __forceinline__ void prologue_phase(LAS unsigned char* lds, int gw, int NGW, int wave, int lane) {
    LAS float* scr = (LAS float*)(lds + wave * 16640);
    constexpr int PTOT = cvt_layer_items(0) + cvt_layer_items(1) + cvt_layer_items(2) + cvt_layer_items(3) - 3 * CVT_TAIL;
    {
        CvtD dA, dB; CvtV vA, vB; int it = gw;
        if (it < PTOT) { pro_desc(dA, lds, it); cvt_load(dA, vA, lane); }
        while (it < PTOT) {
            const int itB = it + NGW; const bool hasB = itB < PTOT;
            if (hasB) { pro_desc(dB, lds, itB); cvt_load(dB, vB, lane); }
            cvt_finish(dA, vA, scr, lane);
            if (!hasB) break;
            const int itA = itB + NGW; const bool hasA = itA < PTOT;
            if (hasA) { pro_desc(dA, lds, itA); cvt_load(dA, vA, lane); }
            cvt_finish(dB, vB, scr, lane);
            it = itA;
        }
    }
    unsigned char* ws = WS_G();
    const float* x = IN_G(0); bf16* xb = (bf16*)(ws + WS_XB); float* stats = (float*)(ws + WS_STATS);
    for (int m = gw; m < MROWS; m += NGW) {
        const f32x4* xr = (const f32x4*)(x + (size_t)m * DM) + 2 * lane; f32x4 v[8]; float s = 0.f;
#pragma unroll
        for (int j = 0; j < 4; ++j) { v[2 * j] = xr[128 * j]; v[2 * j + 1] = xr[128 * j + 1]; }
#pragma unroll
        for (int j = 0; j < 8; ++j) s += (v[j][0] * v[j][0] + v[j][1] * v[j][1]) + (v[j][2] * v[j][2] + v[j][3] * v[j][3]);
        s = wave_sum(s);
        v4u* o16 = (v4u*)(xb + (size_t)m * DM) + lane;
#pragma unroll
        for (int j = 0; j < 4; ++j) { v4u w; w.x = pk2(v[2 * j][0], v[2 * j][1]); w.y = pk2(v[2 * j][2], v[2 * j][3]); w.z = pk2(v[2 * j + 1][0], v[2 * j + 1][1]); w.w = pk2(v[2 * j + 1][2], v[2 * j + 1][3]); o16[64 * j] = w; }
        if (lane < 8) stats[(size_t)m * 8 + lane] = lane == 0 ? s : 0.f;
    }
}
__device__ __forceinline__ void cvt_tail(LAS unsigned char* lds, int L, int cu, int wave, int lane) {
    LAS float* scr = (LAS float*)(lds + wave * 16640);
    const int cnt = cvt_layer_items(L);
    CvtD dA, dB; CvtV vA, vB; int j = cnt - CVT_TAIL + (cu - 128) * NWAVES + wave; const int st = 128 * NWAVES;
    if (j < cnt) { cvt_layer_desc(dA, lds, L, j); cvt_load(dA, vA, lane); }
    while (j < cnt) {
        const int jB = j + st; const bool hasB = jB < cnt;
        if (hasB) { cvt_layer_desc(dB, lds, L, jB); cvt_load(dB, vB, lane); }
        cvt_finish(dA, vA, scr, lane);
        if (!hasB) break;
        const int jA = jB + st; const bool hasA = jA < cnt;
        if (hasA) { cvt_layer_desc(dA, lds, L, jA); cvt_load(dA, vA, lane); }
        cvt_finish(dB, vB, scr, lane);
        j = jA;
    }
}

__device__ __forceinline__ void final_phase(float* out, const bf16* xb, const float* stats, const float* g, int gw, int NGW, int lane) {
    f32x4 gg[8];
#pragma unroll
    for (int j = 0; j < 4; ++j) { gg[2 * j] = ((const f32x4*)g)[2 * (lane + 64 * j)]; gg[2 * j + 1] = ((const f32x4*)g)[2 * (lane + 64 * j) + 1]; }
    for (int m0 = gw; m0 < MROWS; m0 += 4 * NGW) {
        v4u xw[4][4]; float rs[4];
#pragma unroll
        for (int r = 0; r < 4; ++r) { const int m = m0 + r * NGW; if (m < MROWS) { rs[r] = pg8::row_rs(stats, m); const v4u* xr = (const v4u*)(xb + (size_t)m * DM) + lane;
#pragma unroll
            for (int j = 0; j < 4; ++j) xw[r][j] = xr[64 * j]; } }
#pragma unroll
        for (int r = 0; r < 4; ++r) { const int m = m0 + r * NGW; if (m < MROWS) { f32x4* orow = (f32x4*)(out + (size_t)m * DM);
#pragma unroll
            for (int j = 0; j < 4; ++j) { const v4u w = xw[r][j]; const int c4 = 2 * (lane + 64 * j);
                const f32x4 a = (f32x4){bf_lo(w.x), bf_hi(w.x), bf_lo(w.y), bf_hi(w.y)}, b = (f32x4){bf_lo(w.z), bf_hi(w.z), bf_lo(w.w), bf_hi(w.w)};
                orow[c4] = a * rs[r] * gg[2 * j]; orow[c4 + 1] = b * rs[r] * gg[2 * j + 1]; } } }
    }
}

constexpr int A_TILE = 16384, A_BUF = 2 * A_TILE, A_LT_OFF = 2 * A_BUF, A_LT_BYTES = 10 * 8192;
static_assert(A_LT_OFF + A_LT_BYTES + 2304 <= LDS_BYTES - 256, "attention LDS map");
typedef float f32x16 __attribute__((ext_vector_type(16)));
typedef short s16x4 __attribute__((ext_vector_type(4)));
__device__ __forceinline__ s16x4 lds_tr16(const LAS unsigned char* p) { return __builtin_bit_cast(s16x4, __builtin_amdgcn_ds_read_tr16_b64_v4i16((LAS s16x4*)p)); }
__device__ __forceinline__ float xhalf_max(float v) { auto rr = __builtin_amdgcn_permlane32_swap(__float_as_uint(v), __float_as_uint(v), false, false); return fmaxf(__uint_as_float(rr[0]), __uint_as_float(rr[1])); }
__device__ __forceinline__ float xhalf_sum(float v) { auto rr = __builtin_amdgcn_permlane32_swap(__float_as_uint(v), __float_as_uint(v), false, false); return __uint_as_float(rr[0]) + __uint_as_float(rr[1]); }
#define A_MX3(a, b, c) __builtin_fmaxf(__builtin_fmaxf((a), (b)), (c))
__device__ __forceinline__ void attn_phase(const bf16* PROJ, bf16* CAT, const float* relb, LAS unsigned char* lds, int cu, int G, int tid, int wave, int lane) {
    const float C2 = 0.08838834764831845f * 1.4426950408889634f, ISC = 11.313708498984761f;
    const int q32 = lane & 31, hh = lane >> 5;
    const int drow = lane >> 4, dpos = lane & 15;
    const int koff0 = q32 * 256, koff1 = (32 + q32) * 256, kx = q32 & 15;
    const int g4 = lane >> 4, tq = (lane & 15) >> 2, tp = lane & 3;
    const int vrow = 4 * (g4 >> 1) + tq, vlow = 2 * (g4 & 1) + (tp >> 1), vin = 8 * (tp & 1);
    for (int unit = cu; unit < 256; unit += G) {
        const int bh = (unit & 7) | ((unit >> 6) << 3), qc4 = (unit >> 3) & 7, b = bh >> 3, h = bh & 7;
        const int row0 = b * SEQ + qc4 * 256;
        asm volatile("s_waitcnt vmcnt(0) lgkmcnt(0)" ::: "memory"); __builtin_amdgcn_s_barrier(); asm volatile("" ::: "memory");
        { LAS float* LT = (LAS float*)(lds + A_LT_OFF); LAS float* rb = (LAS float*)(lds + A_LT_OFF + A_LT_BYTES);
          for (int x = tid; x < 513; x += NTHREADS) rb[x] = relb[h * 513 + x];
          asm volatile("s_waitcnt lgkmcnt(0)" ::: "memory"); __builtin_amdgcn_s_barrier(); asm volatile("" ::: "memory");
#pragma unroll 4
          for (int x = tid; x < 10 * 2048; x += NTHREADS) { const int e = x >> 11, rem = x & 2047, rq = rem >> 8, ln = (rem & 255) >> 2, c = rem & 3, r = 4 * rq + c;
              const int kj = (r & 3) + 8 * ((r & 15) >> 2) + 4 * (ln >> 5) + 32 * (r >> 4); int idx = 32 * e + (ln & 31) + 256 - kj; idx = idx > 512 ? 512 : idx;
              LT[x] = rb[idx] * ISC; } }
        float bcs = relb[h * 513 + 512] * ISC;
        bf16x8 qf[8];
        { const bf16* qp = PROJ + (size_t)(row0 + 32 * wave + q32) * NAB + h * 128 + 8 * hh;
#pragma unroll
          for (int ds = 0; ds < 8; ++ds) qf[ds] = *(const bf16x8*)(qp + 16 * ds); }
        asm volatile("s_waitcnt vmcnt(0)" ::: "memory");
#pragma unroll
        for (int ds = 0; ds < 8; ++ds) asm volatile("" : "+v"(qf[ds]));
        asm volatile("" : "+v"(bcs));
        const int t0 = qc4 >= 2 ? 0 : 8 - 4 * qc4;
        const int wlo = wave >> 1, whi = wlo + 8;
        const int r0 = 4 * wave + drow, r1 = r0 + 32;
        const bf16* tile0 = PROJ + ((long)(b * SEQ + (4 * qc4 - 8) * 64)) * NAB + 1024 + h * 128;
        const bf16* gk0 = tile0 + (long)r0 * NAB + ((dpos ^ (r0 & 15)) << 3);
        const bf16* gk1 = tile0 + (long)r1 * NAB + ((dpos ^ (r1 & 15)) << 3);
        const bf16* gv0 = tile0 + (long)r0 * NAB + 1024 + ((dpos ^ ((r0 & 3) << 2)) << 3);
        const bf16* gv1 = tile0 + (long)r1 * NAB + 1024 + ((dpos ^ ((r1 & 3) << 2)) << 3);
#define A_DMA(t) do { const long go_ = (long)(t) * 64 * NAB; LAS unsigned char* d_ = lds + ((t) & 1) * A_BUF + wave * 1024; \
            __builtin_amdgcn_global_load_lds((const unsigned*)(gk0 + go_), (LAS unsigned*)(d_), 16, 0, 0); \
            __builtin_amdgcn_global_load_lds((const unsigned*)(gk1 + go_), (LAS unsigned*)(d_ + 8192), 16, 0, 0); \
            __builtin_amdgcn_global_load_lds((const unsigned*)(gv0 + go_), (LAS unsigned*)(d_ + A_TILE), 16, 0, 0); \
            __builtin_amdgcn_global_load_lds((const unsigned*)(gv1 + go_), (LAS unsigned*)(d_ + A_TILE + 8192), 16, 0, 0); } while (0)
        A_DMA(t0);
        float mx = -1e30f, lsum = 0.f;
        f32x16 o[4];
#pragma unroll
        for (int db = 0; db < 4; ++db)
#pragma unroll
            for (int r = 0; r < 16; ++r) o[db][r] = 0.f;
        for (int t = t0; t < 12; ++t) {
            asm volatile("s_waitcnt vmcnt(0) lgkmcnt(0)" ::: "memory"); __builtin_amdgcn_s_barrier(); asm volatile("" ::: "memory");
            if (t + 1 < 12) A_DMA(t + 1);
            if (t >= wlo && t <= whi) {
                const LAS unsigned char* Kb = lds + (t & 1) * A_BUF; const LAS unsigned char* Vb = Kb + A_TILE;
                const int dn = wlo + 8 - t;
                bf16x8 kf[16];
#pragma unroll
                for (int ds = 0; ds < 8; ++ds) { const int cp = ((2 * ds + hh) ^ kx) << 4; kf[2 * ds] = *(const LAS bf16x8*)(Kb + koff0 + cp); kf[2 * ds + 1] = *(const LAS bf16x8*)(Kb + koff1 + cp); }
                f32x16 p0, p1;
                if (dn >= 5) {
#pragma unroll
                    for (int r = 0; r < 16; ++r) { p0[r] = bcs; p1[r] = bcs; }
                } else { const LAS unsigned char* lt = lds + A_LT_OFF + (2 * dn + (wave & 1)) * 8192 + lane * 16;
#pragma unroll
                    for (int rq = 0; rq < 4; ++rq) { const f32x4 a = *(const LAS f32x4*)(lt + rq * 1024), c = *(const LAS f32x4*)(lt + (rq + 4) * 1024);
                        p0[4 * rq] = a[0]; p0[4 * rq + 1] = a[1]; p0[4 * rq + 2] = a[2]; p0[4 * rq + 3] = a[3]; p1[4 * rq] = c[0]; p1[4 * rq + 1] = c[1]; p1[4 * rq + 2] = c[2]; p1[4 * rq + 3] = c[3]; }
                }
                asm volatile("s_waitcnt lgkmcnt(0)" ::: "memory"); __builtin_amdgcn_sched_barrier(0);
#pragma unroll
                for (int ds = 0; ds < 8; ++ds) {
                    p0 = __builtin_amdgcn_mfma_f32_32x32x16_bf16(kf[2 * ds], qf[ds], p0, 0, 0, 0);
                    p1 = __builtin_amdgcn_mfma_f32_32x32x16_bf16(kf[2 * ds + 1], qf[ds], p1, 0, 0, 0);
                }
                __builtin_amdgcn_sched_barrier(0);
                s16x4 vlo[4][4], vhi[4][4];
#pragma unroll
                for (int db = 0; db < 4; ++db) {
                    const LAS unsigned char* vp = Vb + vrow * 256 + ((((db ^ tq) << 2) + vlow) << 4) + vin;
                    const unsigned va = (unsigned)(uintptr_t)vp;
#pragma unroll
                    for (int ks = 0; ks < 4; ++ks) {
                        asm volatile("ds_read_b64_tr_b16 %0, %1 offset:%c2" : "=&v"(vlo[db][ks]) : "v"(va), "i"((16 * ks) * 256) : "memory");
                        asm volatile("ds_read_b64_tr_b16 %0, %1 offset:%c2" : "=&v"(vhi[db][ks]) : "v"(va), "i"((16 * ks + 8) * 256) : "memory"); }
                }
                __builtin_amdgcn_sched_barrier(0);
                float ta = A_MX3(p0[0], p0[1], p1[0]), tb = A_MX3(p0[2], p0[3], p1[1]); ta = A_MX3(ta, p1[2], p1[3]);
#pragma unroll
                for (int r = 4; r < 16; r += 4) { ta = A_MX3(ta, p0[r], p0[r + 1]); tb = A_MX3(tb, p0[r + 2], p0[r + 3]); ta = A_MX3(ta, p1[r], p1[r + 1]); tb = A_MX3(tb, p1[r + 2], p1[r + 3]); }
                const float tm = xhalf_max(fmaxf(ta, tb));
                if (__any(tm > mx)) {
                    const float mn = fmaxf(mx, tm), alpha = __builtin_amdgcn_exp2f((mx - mn) * C2); mx = mn; lsum *= alpha;
#pragma unroll
                    for (int db = 0; db < 4; ++db)
#pragma unroll
                        for (int r = 0; r < 16; ++r) o[db][r] *= alpha;
                }
                const float nm = -mx * C2;
                float rsum = 0.f;
#pragma unroll
                for (int r = 0; r < 16; ++r) { p0[r] = __builtin_amdgcn_exp2f(__builtin_fmaf(p0[r], C2, nm)); p1[r] = __builtin_amdgcn_exp2f(__builtin_fmaf(p1[r], C2, nm)); rsum += p0[r] + p1[r]; }
                lsum += rsum;
                bf16x8 pf[4];
#pragma unroll
                for (int s2 = 0; s2 < 2; ++s2) {
                    v4u a, c;
                    a.x = pk2(p0[8 * s2 + 0], p0[8 * s2 + 1]); a.y = pk2(p0[8 * s2 + 2], p0[8 * s2 + 3]); a.z = pk2(p0[8 * s2 + 4], p0[8 * s2 + 5]); a.w = pk2(p0[8 * s2 + 6], p0[8 * s2 + 7]);
                    c.x = pk2(p1[8 * s2 + 0], p1[8 * s2 + 1]); c.y = pk2(p1[8 * s2 + 2], p1[8 * s2 + 3]); c.z = pk2(p1[8 * s2 + 4], p1[8 * s2 + 5]); c.w = pk2(p1[8 * s2 + 6], p1[8 * s2 + 7]);
                    pf[s2] = __builtin_bit_cast(bf16x8, a); pf[2 + s2] = __builtin_bit_cast(bf16x8, c);
                }
                asm volatile("s_waitcnt lgkmcnt(0)" ::: "memory"); __builtin_amdgcn_sched_barrier(0);
#pragma unroll
                for (int ks = 0; ks < 4; ++ks)
#pragma unroll
                    for (int db = 0; db < 4; ++db) {
                        const s16x4 lo = vlo[db][ks], hi = vhi[db][ks];
                        const bf16x8 vf = (bf16x8){lo[0], lo[1], lo[2], lo[3], hi[0], hi[1], hi[2], hi[3]};
                        o[db] = __builtin_amdgcn_mfma_f32_32x32x16_bf16(vf, pf[ks], o[db], 0, 0, 0);
                    }
                __builtin_amdgcn_sched_barrier(0);
            }
        }
#undef A_DMA
        const float inv = 1.0f / xhalf_sum(lsum);
        bf16* op = CAT + (size_t)(row0 + 32 * wave + q32) * DM + h * 128 + 8 * hh;
#pragma unroll
        for (int db = 0; db < 4; ++db)
#pragma unroll
            for (int rq = 0; rq < 4; rq += 2) {
                unsigned ax = pk2(o[db][4 * rq] * inv, o[db][4 * rq + 1] * inv), ay = pk2(o[db][4 * rq + 2] * inv, o[db][4 * rq + 3] * inv);
                unsigned bx = pk2(o[db][4 * rq + 4] * inv, o[db][4 * rq + 5] * inv), by = pk2(o[db][4 * rq + 6] * inv, o[db][4 * rq + 7] * inv);
                { auto r = __builtin_amdgcn_permlane32_swap(ax, bx, false, false); ax = r[0]; bx = r[1]; }
                { auto r = __builtin_amdgcn_permlane32_swap(ay, by, false, false); ay = r[0]; by = r[1]; }
                v4u w; w.x = ax; w.y = ay; w.z = bx; w.w = by;
                *(v4u*)(op + 32 * db + 8 * rq) = w; }
    }
    asm volatile("s_waitcnt vmcnt(0) lgkmcnt(0)" ::: "memory"); __builtin_amdgcn_s_barrier(); asm volatile("" ::: "memory");
}

__device__ __forceinline__ void conv_unpack(const v4u a, float (&z)[8]) {
    z[0] = bf_lo(a.x); z[1] = bf_hi(a.x); z[2] = bf_lo(a.y); z[3] = bf_hi(a.y); z[4] = bf_lo(a.z); z[5] = bf_hi(a.z); z[6] = bf_lo(a.w); z[7] = bf_hi(a.w);
}
__device__ __forceinline__ void conv_phase(const bf16* PROJ, bf16* CAT, const float* cw  , int gtid, int nthr) {
    for (int idx = gtid; idx < (MROWS / 8) * 128; idx += nthr) {
        const int c8 = (idx & 127) * 8, r0 = (idx >> 7) * 8, t0 = r0 & 2047;
        float w[3][8];
#pragma unroll
        for (int j = 0; j < 3; ++j) { const f32x4 a = *(const f32x4*)(cw + j * 1024 + c8), b = *(const f32x4*)(cw + j * 1024 + c8 + 4);
            w[j][0] = a[0]; w[j][1] = a[1]; w[j][2] = a[2]; w[j][3] = a[3]; w[j][4] = b[0]; w[j][5] = b[1]; w[j][6] = b[2]; w[j][7] = b[3]; }
        v4u zz_[10], bg_[8];
#pragma unroll
        for (int k = 0; k < 10; ++k) { const int rr = r0 - 2 + k;
            if (k >= 2 || t0 > 0) zz_[k] = *(const v4u*)(PROJ + (size_t)rr * NAB + 4096 + c8);
            else zz_[k] = (v4u){0u, 0u, 0u, 0u}; }
#pragma unroll
        for (int k = 0; k < 8; ++k) bg_[k] = *(const v4u*)(PROJ + (size_t)(r0 + k) * NAB + 3072 + c8);
        float z2[8], z1[8], z0[8];
        conv_unpack(zz_[0], z2); conv_unpack(zz_[1], z1);
#pragma unroll
        for (int k = 0; k < 8; ++k) {
            conv_unpack(zz_[k + 2], z0);
            float y[8];
#pragma unroll
            for (int e = 0; e < 8; ++e) y[e] = w[0][e] * z2[e] + w[1][e] * z1[e] + w[2][e] * z0[e];
            const v4u bg = bg_[k];
            v4u o; o.x = pk2(y[0] * bf_lo(bg.x), y[1] * bf_hi(bg.x)); o.y = pk2(y[2] * bf_lo(bg.y), y[3] * bf_hi(bg.y));
            o.z = pk2(y[4] * bf_lo(bg.z), y[5] * bf_hi(bg.z)); o.w = pk2(y[6] * bf_lo(bg.w), y[7] * bf_hi(bg.w));
            *(v4u*)(CAT + (size_t)(r0 + k) * DM + 1024 + c8) = o;
#pragma unroll
            for (int e = 0; e < 8; ++e) { z2[e] = z1[e]; z1[e] = z0[e]; }
        }
    }
}

constexpr int G_WP = 136, G_VP = 260;
constexpr int G_W_OFF = 0, G_V_OFF = 128 * G_WP * 2, G_ST_OFF = G_V_OFF + 128 * G_VP * 2;
__device__ __forceinline__ void gmlp_phase(const bf16* Z, bf16* US, const float* lnp, const float* w_s, const float* b_s, const float* ln_g, const float* ln_b,
                                           LAS unsigned char* lds, int cu, int G, int tid, int wave, int lane) {
    LAS bf16* wl = (LAS bf16*)(lds + G_W_OFF); LAS bf16* vl = (LAS bf16*)(lds + G_V_OFF); LAS float* st = (LAS float*)(lds + G_ST_OFF);
    const int fr = lane & 15, fq = lane >> 4;
    for (int unit = cu; unit < 512; unit += G) {
        const int nb = unit >> 3, g = unit & 7, row0 = nb * 128, ch0 = g * 256;
        { f32x4 wv[8];
#pragma unroll
          for (int p = 0; p < 8; ++p) { const int idx = tid + 512 * p, t = idx >> 5, s4 = (idx & 31) * 4; wv[p] = *(const f32x4*)(w_s + ((size_t)g * 128 + t) * 128 + s4); }
#pragma unroll
          for (int p = 0; p < 8; ++p) { const int idx = tid + 512 * p, t = idx >> 5, s4 = (idx & 31) * 4; f32x4 w = wv[p];
            if ((s4 >> 6) > (t >> 6)) w = (f32x4){0.f, 0.f, 0.f, 0.f};
            v2u o; o.x = pk2(w[0], w[1]); o.y = pk2(w[2], w[3]); *(LAS v2u*)(wl + t * G_WP + s4) = o; } }
        if (tid < 128) { const f32x4* p4 = (const f32x4*)(lnp + (size_t)(row0 + tid) * 64); float s = 0.f, q = 0.f;
#pragma unroll
            for (int j = 0; j < 16; ++j) { const f32x4 a = p4[j]; s += a[0] + a[2]; q += a[1] + a[3]; }
            const float mean = s * (1.0f / 2048.0f), var = q * (1.0f / 2048.0f) - mean * mean;
            st[tid * 2] = mean; st[tid * 2 + 1] = __builtin_amdgcn_rsqf(var + EPS); }
        LDS_WAIT(); __syncthreads();
        { const int c8 = (tid & 31) * 8;
          const f32x4 g0 = *(const f32x4*)(ln_g + ch0 + c8), g1 = *(const f32x4*)(ln_g + ch0 + c8 + 4), b0 = *(const f32x4*)(ln_b + ch0 + c8), b1 = *(const f32x4*)(ln_b + ch0 + c8 + 4);
          v4u vv[8]; float muv[8], rsv[8];
#pragma unroll
          for (int p = 0; p < 8; ++p) { const int s = (tid >> 5) + 16 * p; vv[p] = *(const v4u*)(Z + (size_t)(row0 + s) * NC + 2048 + ch0 + c8); muv[p] = st[s * 2]; rsv[p] = st[s * 2 + 1]; }
#pragma unroll
          for (int p = 0; p < 8; ++p) { const int s = (tid >> 5) + 16 * p; const v4u v = vv[p]; const float mu = muv[p], rstd = rsv[p];
              v2u o0, o1;
              o0.x = pk2((bf_lo(v.x) - mu) * rstd * g0[0] + b0[0], (bf_hi(v.x) - mu) * rstd * g0[1] + b0[1]); o0.y = pk2((bf_lo(v.y) - mu) * rstd * g0[2] + b0[2], (bf_hi(v.y) - mu) * rstd * g0[3] + b0[3]);
              o1.x = pk2((bf_lo(v.z) - mu) * rstd * g1[0] + b1[0], (bf_hi(v.z) - mu) * rstd * g1[1] + b1[1]); o1.y = pk2((bf_lo(v.w) - mu) * rstd * g1[2] + b1[2], (bf_hi(v.w) - mu) * rstd * g1[3] + b1[3]);
              *(LAS v2u*)(vl + s * G_VP + c8) = o0; *(LAS v2u*)(vl + s * G_VP + c8 + 4) = o1; } }
        LDS_WAIT(); __syncthreads();
        pg8::f32x4 acc[2][8];
#pragma unroll
        for (int a = 0; a < 2; ++a)
#pragma unroll
            for (int b = 0; b < 8; ++b) acc[a][b] = (pg8::f32x4){0.f, 0.f, 0.f, 0.f};
#pragma unroll
        for (int ks = 0; ks < 4; ++ks) {
            bf16x8 vf[2];
#pragma unroll
            for (int dt = 0; dt < 2; ++dt) { const LAS bf16* p = vl + (32 * ks + 8 * fq) * G_VP + wave * 32 + 8 * (fr >> 2) + 4 * dt + (fr & 3);
#pragma unroll
                for (int j = 0; j < 8; ++j) vf[dt][j] = (short)p[j * G_VP]; }
#pragma unroll
            for (int tt = 0; tt < 8; ++tt) { const bf16x8 wf = *(const LAS bf16x8*)(wl + (16 * tt + fr) * G_WP + 32 * ks + 8 * fq);
                acc[0][tt] = __builtin_amdgcn_mfma_f32_16x16x32_bf16(vf[0], wf, acc[0][tt], 0, 0, 0);
                acc[1][tt] = __builtin_amdgcn_mfma_f32_16x16x32_bf16(vf[1], wf, acc[1][tt], 0, 0, 0); }
        }
        { const size_t col = ch0 + wave * 32 + 8 * fq;
          v4u uu[8]; float bsv[8];
#pragma unroll
          for (int tt = 0; tt < 8; ++tt) { const int t = 16 * tt + fr; bsv[tt] = b_s[g * 128 + t]; uu[tt] = *(const v4u*)(Z + (size_t)(row0 + t) * NC + col); }
#pragma unroll
          for (int tt = 0; tt < 8; ++tt) { const int t = 16 * tt + fr; const float bs = bsv[tt]; const v4u u4 = uu[tt];
            const pg8::f32x4 a = acc[0][tt], c = acc[1][tt]; v4u o;
            o.x = pk2(bf_lo(u4.x) * (a[0] + bs), bf_hi(u4.x) * (a[1] + bs)); o.y = pk2(bf_lo(u4.y) * (a[2] + bs), bf_hi(u4.y) * (a[3] + bs));
            o.z = pk2(bf_lo(u4.z) * (c[0] + bs), bf_hi(u4.z) * (c[1] + bs)); o.w = pk2(bf_lo(u4.w) * (c[2] + bs), bf_hi(u4.w) * (c[3] + bs));
            *(v4u*)(US + (size_t)(row0 + t) * DM + col) = o; } }
        LDS_WAIT(); __syncthreads();
    }
}

#define XB_TMO      128
#define XB_XCNT(j)  (256  + 64 * (j))
#define XB_XSUB(j)  (1280 + 64 * (j))
#define XB_XGEN(j)  (2304 + 64 * (j))
#define XB_TOP      3328
#define XB_TOPGEN   3392
#define XCD_BAR_WORDS 3456
#define XB_SPIN_CAP (1u << 18)

__device__ __forceinline__ unsigned xb_ld(unsigned* p)              { return __hip_atomic_load(p, __ATOMIC_RELAXED, __HIP_MEMORY_SCOPE_AGENT); }
__device__ __forceinline__ unsigned xb_add(unsigned* p, unsigned v) { return __hip_atomic_fetch_add(p, v, __ATOMIC_RELAXED, __HIP_MEMORY_SCOPE_AGENT); }
__device__ __forceinline__ unsigned xb_xcc_id() { return (unsigned)__builtin_amdgcn_s_getreg((3 << 11) | 20) & 0xFu; }
#define XB_SPIN(cond, bar) do { unsigned _sp = 0; while (cond) { __builtin_amdgcn_s_sleep(1); \
    if ((++_sp & 255u) == 0u) { if (xb_ld(&(bar)[XB_TMO])) break; if (_sp > XB_SPIN_CAP) { atomicAdd(&(bar)[XB_TMO], 1u); break; } } } } while (0)

struct XcdBarrier {
    unsigned* bar; unsigned x;
    volatile LAS unsigned* st;
};

__device__ __forceinline__ XcdBarrier xcd_barrier_post(unsigned* bar, volatile LAS unsigned* st) {
    XcdBarrier b; b.bar = bar; b.x = xb_xcc_id(); b.st = st;
    if (threadIdx.x == 0) (void)xb_add(&bar[XB_XCNT(b.x)], 1u);
    return b;
}
__device__ __forceinline__ void xcd_barrier_complete(unsigned* bar, unsigned x, unsigned& nloc, unsigned& nx) {
    const unsigned G = gridDim.x * gridDim.y * gridDim.z;
    unsigned sum, cnt, mine, sp = 0u;
    for (;;) {
        sum = 0u; cnt = 0u; mine = 0u;
#pragma unroll
        for (unsigned j = 0; j < 16; ++j) { const unsigned c = xb_ld(&bar[XB_XCNT(j)]); sum += c; cnt += (c > 0u) ? 1u : 0u; mine = (j == x) ? c : mine; }
        if (sum == G) break;
        __builtin_amdgcn_s_sleep(1);
        if ((++sp & 255u) == 0u) { if (xb_ld(&bar[XB_TMO])) break; if (sp > XB_SPIN_CAP) { atomicAdd(&bar[XB_TMO], 1u); break; } }
    }
    nloc = mine > 0u ? mine : 1u; nx = cnt > 0u ? cnt : 1u;
}

__device__ __forceinline__ void xcd_barrier(const XcdBarrier& b) {
    asm volatile("s_waitcnt vmcnt(0)" ::: "memory");
    __syncthreads();
    if (threadIdx.x == 0) {
        unsigned* bar = b.bar;
        __builtin_amdgcn_s_waitcnt(0);
        unsigned nloc = b.st[0], nx = b.st[1];
        if (nloc == 0u) { xcd_barrier_complete(bar, b.x, nloc, nx); b.st[0] = nloc; b.st[1] = nx; }
        const unsigned old = xb_add(&bar[XB_XSUB(b.x)], 1u);
        const unsigned gen = old / nloc;
        if (old + 1u == (gen + 1u) * nloc) {
            __builtin_amdgcn_fence(__ATOMIC_RELEASE, "agent");
            asm volatile("s_waitcnt vmcnt(0)" ::: "memory");
            const unsigned og = xb_add(&bar[XB_TOP], 1u);
            const unsigned tg = og / nx;
            if (og + 1u == (tg + 1u) * nx) xb_add(&bar[XB_TOPGEN], 1u);
            else XB_SPIN(xb_ld(&bar[XB_TOPGEN]) == tg, bar);
            __builtin_amdgcn_fence(__ATOMIC_ACQUIRE, "agent");
            xb_add(&bar[XB_XGEN(b.x)], 1u);
            asm volatile("s_waitcnt vmcnt(0)" ::: "memory");
        } else {
            XB_SPIN(xb_ld(&bar[XB_XGEN(b.x)]) == gen, bar);
            __builtin_amdgcn_fence(__ATOMIC_ACQUIRE, "agent");
            asm volatile("s_waitcnt vmcnt(0)" ::: "memory");
        }
    }
    __syncthreads();
}

constexpr int CW_BAR = 1024;
__global__ void __launch_bounds__(NTHREADS, 2) mega_fwd(Args args_unused) {
    extern __shared__ __attribute__((aligned(16))) unsigned char lds_raw[];
    LAS unsigned char* lds = (LAS unsigned char*)lds_raw;
    cg::grid_group grid = cg::this_grid();
    if ((int)threadIdx.x < (int)(sizeof(Args) / 4)) ((LAS unsigned*)(lds + TBL_OFF))[threadIdx.x] = ((const unsigned*)__builtin_amdgcn_kernarg_segment_ptr())[threadIdx.x];
    if (threadIdx.x >= 40 && threadIdx.x < 48) ((LAS unsigned*)(lds + TBL_OFF))[threadIdx.x] = 0u;
    LDS_WAIT(); __syncthreads();
    if (threadIdx.x == 0) { unsigned* bar0 = (unsigned*)(WS_() + WS_CTL) + CW_BAR; (void)xb_add(&bar0[XB_XCNT(xb_xcc_id())], 1u); }
    LAS unsigned char* const lds_base = lds;
    const int lo = (int)tbl_u32(lds, 38), hi = (int)tbl_u32(lds, 39);
    for (int ph = lo; ph < hi; ++ph) {
        int tid = threadIdx.x; asm volatile("" : "+v"(tid));
        int cu = blockIdx.x; asm volatile("" : "+s"(cu));
        int G = gridDim.x; asm volatile("" : "+s"(G));
        unsigned ldso = 0; asm volatile("" : "+s"(ldso)); LAS unsigned char* lds = lds_base + ldso;
        const int lane = tid & 63, wave = __builtin_amdgcn_readfirstlane(tid >> 6);
        const int gw = cu * NWAVES + wave, NGW = G * NWAVES;
        if (ph == 0) { prologue_phase(lds, gw, NGW, wave, lane); }
        else if (ph == 21) { final_phase(OUT_G(), (const bf16*)(WS_G() + WS_XB), (const float*)(WS_G() + WS_STATS), IN_G(16), gw, NGW, lane); }
        else {
            const int l = (ph - 1) / 5, s = (ph - 1) % 5, i = l >> 1; const bool even = (l & 1) == 0;
#define WSP_G(T, off) ((T*)(WS_G() + (off)))
#define WSP_F(T, off) ((T*)(WS_() + (off)))
            if (s == 0 && even) {
                pg8::Gemm g{WSP_G(bf16, WS_XB), WSP_G(const bf16, WS_WAB_IN) + (size_t)i * NAB * DM, MROWS, NAB, DM}; pg8::StaticOrder S; S.init(MROWS, NAB, G, cu);
                const float* stats = WSP_G(const float, WS_STATS);
                int pm0; { pg8::Unit u0_; pm0 = S.next(0, u0_) ? u0_.pm : -1; }
                pg8::EpiScaleBf16 E{WSP_G(bf16, WS_PROJ), NAB, stats, (const LAS float*)(lds + RSTAB_OFF), pm0, 16};
                pg8::gemm_phase<pg8::EpiScaleBf16, pg8::StaticOrder, PG8_ALIGN, PG8_SP2>(lds, g, S, E, tid);
            } else if (s == 0) {
                pg8::Gemm g{WSP_G(bf16, WS_XB), WSP_G(const bf16, WS_WC_IN) + (size_t)i * NC * DM, MROWS, NC, DM}; pg8::StaticOrder S; S.init(MROWS, NC, G, cu);
                const float* stats = WSP_G(const float, WS_STATS);
                int pm0; { pg8::Unit u0_; pm0 = S.next(0, u0_) ? u0_.pm : -1; }
                pg8::EpiGeluLN E{WSP_G(bf16, WS_PROJ), NC, stats, WSP_G(float, WS_LNP), (const LAS float*)(lds + RSTAB_OFF), pm0};
                pg8::gemm_phase<pg8::EpiGeluLN, pg8::StaticOrder, PG8_ALIGN, PG8_SP2>(lds, g, S, E, tid);
            } else if (s == 1 && even) {
                attn_phase(WSP_F(const bf16, WS_PROJ), WSP_F(bf16, WS_CAT), IN_(3) + (size_t)i * 8 * 513, lds, cu, G, tid, wave, lane);
                conv_phase(WSP_G(const bf16, WS_PROJ), WSP_G(bf16, WS_CAT), IN_G(4) + (size_t)i * 3 * 1024, cu * NTHREADS + tid, G * NTHREADS);
            } else if (s == 1) {
                gmlp_phase(WSP_G(const bf16, WS_PROJ), WSP_G(bf16, WS_CAT), WSP_G(const float, WS_LNP), IN_G(9) + (size_t)i * 8 * 128 * 128, IN_G(10) + (size_t)i * 8 * 128, IN_G(7) + (size_t)i * DM, IN_G(8) + (size_t)i * DM, lds, cu, G, tid, wave, lane);
            } else if (s == 3) {
                pg8::Gemm g{WSP_G(bf16, WS_XB), WSP_G(const bf16, WS_WGU) + (size_t)l * NGU * DM, MROWS, NGU, DM}; pg8::StaticOrder S; S.init(MROWS, NGU, G, cu);
                const float* stats = WSP_G(const float, WS_STATS);
                int pm0; { pg8::Unit u0_; pm0 = S.next(0, u0_) ? u0_.pm : -1; }
                pg8::EpiSwiGLU E{WSP_G(bf16, WS_HID), FFH, stats, (const LAS float*)(lds + RSTAB_OFF), pm0};
                pg8::gemm_phase<pg8::EpiSwiGLU, pg8::StaticOrder, PG8_ALIGN, PG8_SP2>(lds, g, S, E, tid);
                if (CVT_TAIL > 0 && l < 3 && cu >= 128 && G == 256) cvt_tail(lds, l + 1, cu, wave, lane);
            } else {
                unsigned char* wsg = WS_G();
                const bf16* Aop = s == 2 ? (const bf16*)(wsg + WS_CAT) : (const bf16*)(wsg + WS_HID); const int K = s == 2 ? DM : FFH;
                const bf16* Bop = s == 4 ? (const bf16*)(wsg + WS_WD) + (size_t)l * DM * FFH : (even ? (const bf16*)(wsg + WS_WAB_OUT) + (size_t)i * DM * DM : (const bf16*)(wsg + WS_WC_OUT) + (size_t)i * DM * DM);
                float* outp = (float*)(GAS float*)nullptr;
                pg8::Gemm g{Aop, Bop, MROWS, DM, K}; pg8::StaticOrder S; S.init(MROWS, DM, G, cu);
                pg8::EpiResidual E{(bf16*)(wsg + WS_XB), outp, (float*)(wsg + WS_STATS), DM};
                pg8::gemm_phase<pg8::EpiResidual, pg8::StaticOrder, false, PG8_SP2>(lds, g, S, E, tid);
            }
        }
        if (ph + 1 < hi) {
            if (hi > 64) grid.sync();
            else {    XcdBarrier xb_; xb_.bar = (unsigned*)(WS_() + WS_CTL) + CW_BAR; xb_.x = xb_xcc_id(); xb_.st = (volatile LAS unsigned*)(lds_base + TBL_OFF + 160); xcd_barrier(xb_); }
        }
    }
}

#ifndef MK_N_LAUNCHES
#define MK_N_LAUNCHES 1
#endif
extern "C" void kernel_launch(void* const* d_in, const int* in_sizes, int n_in, void* d_out, int out_size, void* d_ws, size_t ws_size, hipStream_t stream) {
    static int ready = 0;
    if (ready == 0) {
        if (n_in != 17 || in_sizes[0] != MROWS * DM || out_size != MROWS * DM || ws_size < WS_END) { fprintf(stderr, "kernel_launch: unexpected shapes (n_in %d, in0 %d, out %d, ws %zu)\n", n_in, n_in > 0 ? in_sizes[0] : -1, out_size, ws_size); ready = -1; return; }
        if (hipFuncSetAttribute((const void*)mega_fwd, hipFuncAttributeMaxDynamicSharedMemorySize, LDS_BYTES) != hipSuccess) { fprintf(stderr, "kernel_launch: hipFuncSetAttribute failed\n"); ready = -1; return; }
        int per_cu = 0;
        if (hipOccupancyMaxActiveBlocksPerMultiprocessor(&per_cu, (const void*)mega_fwd, NTHREADS, LDS_BYTES) != hipSuccess || per_cu < 1) fprintf(stderr, "kernel_launch: occupancy query says %d\n", per_cu);
        (void)hipGetLastError();
        ready = 1;
    }
    if (ready < 0) return;
    if (hipMemsetAsync((char*)d_ws + WS_CTL, 0, 65536, stream) != hipSuccess) { fprintf(stderr, "kernel_launch: memset failed\n"); return; }
    Args a{};
    for (int i = 0; i < 17; ++i) a.in[i] = (const float*)d_in[i];
    a.out = (float*)d_out; a.ws = (unsigned char*)d_ws;
    const int grid = 256;
#if MK_N_LAUNCHES == 1
    a.ph_lo = 0; a.ph_hi = 22;
    void* kargs[] = {&a};
    hipError_t e = hipLaunchCooperativeKernel((const void*)mega_fwd, dim3(grid), dim3(NTHREADS), kargs, LDS_BYTES, stream);
    if (e != hipSuccess) fprintf(stderr, "kernel_launch: cooperative launch failed: %s\n", hipGetErrorString(e));
#else
    for (int ph = 0; ph < 22; ++ph) { a.ph_lo = ph; a.ph_hi = ph + 1; hipLaunchKernelGGL(mega_fwd, dim3(grid), dim3(NTHREADS), LDS_BYTES, stream, a); }
#endif
}
```
